# Optimizing an MI355X kernel written in HIP

```python
import math
import jax, jax.numpy as jnp
from jax import lax
import numpy as np

D_MODEL = 1024
BATCH = 4
SEQ = 4096
DEPTH = 1
DEC_BATCH = 16
DEC_SEQ = 4096
PAST_LEN = 128

MLA_HEADS = 8
QK_NOPE = 64
QK_ROPE = 32
QK_DIM = QK_NOPE + QK_ROPE
V_HEAD = 64
Q_LORA = 384
KV_LORA = 256
MLA_W = MLA_HEADS * V_HEAD
ROPE_THETA = 10000.0
ATTN_BLOCK = 128
SSM_GROUP = 16
SSM_W = 256
SSM_GROUPS = SSM_W // SSM_GROUP
SSM_STATE = 64
SSM_DT_MIN = 0.001
SSM_DT_MAX = 0.1
MEM_TOKENS = 256
MEM_HEADS = 4
MEM_HD = 64
MEM_W = MEM_HEADS * MEM_HD
N_BRANCH = 3
FF = -(-8 * D_MODEL // (3 * 256)) * 256
EPS = 1e-6
OFF_Q = Q_LORA
OFF_KV = OFF_Q + KV_LORA
OFF_KR = OFF_KV + QK_ROPE
OFF_SSM = OFF_KR + SSM_W
OFF_MEM = OFF_SSM + MEM_W
N_IN = OFF_MEM + N_BRANCH * D_MODEL

kernel_name = "hybrid_mla_s5_memory_encoder"


def _rmsnorm(x, g):
    xf = x.astype(jnp.float32)
    xf = xf * lax.rsqrt(jnp.mean(xf * xf, axis=-1, keepdims=True) + EPS)
    return (xf * g.astype(jnp.float32)).astype(x.dtype)


def _rope_tables(length):
    inv = 1.0 / (ROPE_THETA ** (jnp.arange(0, QK_ROPE, 2, dtype=jnp.float32) / QK_ROPE))
    ang = jnp.arange(length, dtype=jnp.float32)[:, None] * inv[None, :]
    return jnp.cos(ang), jnp.sin(ang)


def _rope(x, cos, sin):
    x1, x2 = jnp.split(x.astype(jnp.float32), 2, axis=-1)
    c = cos[None, :, None, :]
    s = sin[None, :, None, :]
    return jnp.concatenate([x1 * c - x2 * s, x1 * s + x2 * c], axis=-1).astype(x.dtype)


def _blocked_attention(q, k, v, scale):
    b, l, h, dk = q.shape
    nb = l // ATTN_BLOCK
    qb = q.reshape(b, nb, ATTN_BLOCK, h, dk).transpose(1, 0, 2, 3, 4)

    def one_block(qblk):
        s = jnp.einsum('bqhd,bkhd->bhqk', qblk, k, preferred_element_type=jnp.float32) * scale
        p = jax.nn.softmax(s, axis=-1).astype(v.dtype)
        return jnp.einsum('bhqk,bkhd->bqhd', p, v)

    o = lax.map(one_block, qb)
    return o.transpose(1, 0, 2, 3, 4).reshape(b, l, h, v.shape[-1])


def _s5_direction(u, lam_re, lam_im, log_step, b_re, b_im, c_re, c_im, reverse):
    l = u.shape[1]
    dt = jnp.exp(log_step)[:, None]
    mag = jnp.exp(lam_re * dt)
    ab_re = mag * jnp.cos(lam_im * dt)
    ab_im = mag * jnp.sin(lam_im * dt)
    den = lam_re * lam_re + lam_im * lam_im
    n_re = ab_re - 1.0
    z_re = (n_re * lam_re + ab_im * lam_im) / den
    z_im = (ab_im * lam_re - n_re * lam_im) / den
    bb_re = z_re[..., None] * b_re - z_im[..., None] * b_im
    bb_im = z_re[..., None] * b_im + z_im[..., None] * b_re
    bu_re = jnp.einsum('blgh,gph->blgp', u, bb_re)
    bu_im = jnp.einsum('blgh,gph->blgp', u, bb_im)
    a_re = jnp.broadcast_to(ab_re[None, None], (1, l) + ab_re.shape)
    a_im = jnp.broadcast_to(ab_im[None, None], (1, l) + ab_im.shape)

    def combine(e1, e2):
        ar1, ai1, br1, bi1 = e1
        ar2, ai2, br2, bi2 = e2
        return (ar2 * ar1 - ai2 * ai1,
                ar2 * ai1 + ai2 * ar1,
                ar2 * br1 - ai2 * bi1 + br2,
                ar2 * bi1 + ai2 * br1 + bi2)

    _, _, x_re, x_im = lax.associative_scan(combine, (a_re, a_im, bu_re, bu_im), axis=1, reverse=reverse)
    return jnp.einsum('blgp,ghp->blgh', x_re, c_re) - jnp.einsum('blgp,ghp->blgh', x_im, c_im)


def _layer(x, mem, cos, sin, p):
    (norm_mix_g, norm_mem_g, w_in, q_lora_norm_g, kv_lora_norm_g, w_uq, w_ukv, mla_q_norm_g, mla_k_norm_g,
     ssm_lambda_re, ssm_lambda_im, ssm_log_step, ssm_b_re, ssm_b_im, ssm_c_re, ssm_c_im, ssm_d, ssm_w_glu,
     w_mem_kv, mem_q_norm_g, mem_k_norm_g, w_br_attn, w_br_ssm, w_br_mem, w_out,
     norm_ffn_g, w_ffn_gate, w_ffn_up, w_ffn_down) = p
    b, l, d = x.shape
    h = _rmsnorm(x, norm_mix_g)
    z = h @ w_in
    c_q, c_kv, k_rope, u, q_mem, gate_logits = jnp.split(z, (OFF_Q, OFF_KV, OFF_KR, OFF_SSM, OFF_MEM), axis=-1)

    q = (_rmsnorm(c_q, q_lora_norm_g) @ w_uq).reshape(b, l, MLA_HEADS, QK_DIM)
    kv = (_rmsnorm(c_kv, kv_lora_norm_g) @ w_ukv).reshape(b, l, MLA_HEADS, QK_NOPE + V_HEAD)
    k_nope, v = kv[..., :QK_NOPE], kv[..., QK_NOPE:]
    k = jnp.concatenate([k_nope, jnp.broadcast_to(k_rope[:, :, None, :], (b, l, MLA_HEADS, QK_ROPE))], axis=-1)
    q = _rmsnorm(q, mla_q_norm_g)
    k = _rmsnorm(k, mla_k_norm_g)
    q = jnp.concatenate([q[..., :QK_NOPE], _rope(q[..., QK_NOPE:], cos, sin)], axis=-1)
    k = jnp.concatenate([k[..., :QK_NOPE], _rope(k[..., QK_NOPE:], cos, sin)], axis=-1)
    o_attn = _blocked_attention(q, k, v, QK_DIM ** -0.5).reshape(b, l, MLA_W)

    ug = u.reshape(b, l, SSM_GROUPS, SSM_GROUP)
    y_fwd = _s5_direction(ug, ssm_lambda_re[0], ssm_lambda_im[0], ssm_log_step[0],
                          ssm_b_re[0], ssm_b_im[0], ssm_c_re[0], ssm_c_im[0], False)
    y_bwd = _s5_direction(ug, ssm_lambda_re[1], ssm_lambda_im[1], ssm_log_step[1],
                          ssm_b_re[1], ssm_b_im[1], ssm_c_re[1], ssm_c_im[1], True)
    y = (y_fwd + y_bwd).reshape(b, l, SSM_W) + ssm_d * u
    y = jax.nn.gelu(y)
    o_ssm = y * jax.nn.sigmoid(y @ ssm_w_glu)

    m_tok = mem.shape[1]
    mkv = _rmsnorm(mem, norm_mem_g) @ w_mem_kv
    mk = _rmsnorm(mkv[..., :MEM_W].reshape(b, m_tok, MEM_HEADS, MEM_HD), mem_k_norm_g)
    mv = mkv[..., MEM_W:].reshape(b, m_tok, MEM_HEADS, MEM_HD)
    mq = _rmsnorm(q_mem.reshape(b, l, MEM_HEADS, MEM_HD), mem_q_norm_g)
    s = jnp.einsum('blhd,bmhd->bhlm', mq, mk, preferred_element_type=jnp.float32) * (MEM_HD ** -0.5)
    pm = jax.nn.softmax(s, axis=-1).astype(mv.dtype)
    o_mem = jnp.einsum('bhlm,bmhd->blhd', pm, mv).reshape(b, l, MEM_W)

    gates = jax.nn.sigmoid(gate_logits.astype(jnp.float32)).astype(x.dtype).reshape(b, l, N_BRANCH, d)
    merged = (gates[:, :, 0] * (o_attn @ w_br_attn)
              + gates[:, :, 1] * (o_ssm @ w_br_ssm)
              + gates[:, :, 2] * (o_mem @ w_br_mem))
    x = x + merged @ w_out

    h2 = _rmsnorm(x, norm_ffn_g)
    x = x + (jax.nn.silu(h2 @ w_ffn_gate) * (h2 @ w_ffn_up)) @ w_ffn_down
    return x


def setup_inputs(seed: int = 0) -> dict:
    key = jax.random.key(seed)
    ks = jax.random.split(key, 40)
    f32 = jnp.float32

    def nrm(k, shape, scale):
        return jax.random.normal(k, shape, f32) * scale

    def gain(k, shape):
        return 1.0 + 0.02 * jax.random.normal(k, shape, f32)

    n_idx = jnp.arange(SSM_STATE, dtype=f32)
    return {
        "x_prompt": nrm(ks[0], (BATCH, SEQ, D_MODEL), 1.0),
        "x_sample": nrm(ks[1], (DEC_BATCH, DEC_SEQ, D_MODEL), 1.0),
        "mem_prompt": nrm(ks[2], (BATCH, MEM_TOKENS, D_MODEL), 1.0),
        "mem_sample": nrm(ks[3], (DEC_BATCH, MEM_TOKENS, D_MODEL), 1.0),
        "norm_mix_g": gain(ks[4], (DEPTH, D_MODEL)),
        "norm_mem_g": gain(ks[5], (DEPTH, D_MODEL)),
        "w_in": nrm(ks[6], (DEPTH, D_MODEL, N_IN), D_MODEL ** -0.5),
        "q_lora_norm_g": gain(ks[7], (DEPTH, Q_LORA)),
        "kv_lora_norm_g": gain(ks[8], (DEPTH, KV_LORA)),
        "w_uq": nrm(ks[9], (DEPTH, Q_LORA, MLA_HEADS * QK_DIM), Q_LORA ** -0.5),
        "w_ukv": nrm(ks[10], (DEPTH, KV_LORA, MLA_HEADS * (QK_NOPE + V_HEAD)), KV_LORA ** -0.5),
        "mla_q_norm_g": gain(ks[11], (DEPTH, QK_DIM)),
        "mla_k_norm_g": gain(ks[12], (DEPTH, QK_DIM)),
        "ssm_lambda_re": -0.5 + 0.01 * jax.random.normal(ks[13], (DEPTH, 2, SSM_GROUPS, SSM_STATE), f32),
        "ssm_lambda_im": math.pi * n_idx + 0.01 * jax.random.normal(ks[14], (DEPTH, 2, SSM_GROUPS, SSM_STATE), f32),
        "ssm_log_step": jax.random.uniform(ks[15], (DEPTH, 2, SSM_GROUPS), f32,
                                           minval=math.log(SSM_DT_MIN), maxval=math.log(SSM_DT_MAX)),
        "ssm_b_re": nrm(ks[16], (DEPTH, 2, SSM_GROUPS, SSM_STATE, SSM_GROUP), (2 * SSM_GROUP) ** -0.5),
        "ssm_b_im": nrm(ks[17], (DEPTH, 2, SSM_GROUPS, SSM_STATE, SSM_GROUP), (2 * SSM_GROUP) ** -0.5),
        "ssm_c_re": nrm(ks[18], (DEPTH, 2, SSM_GROUPS, SSM_GROUP, SSM_STATE), (2 * SSM_STATE) ** -0.5),
        "ssm_c_im": nrm(ks[19], (DEPTH, 2, SSM_GROUPS, SSM_GROUP, SSM_STATE), (2 * SSM_STATE) ** -0.5),
        "ssm_d": nrm(ks[20], (DEPTH, SSM_W), 1.0),
        "ssm_w_glu": nrm(ks[21], (DEPTH, SSM_W, SSM_W), SSM_W ** -0.5),
        "w_mem_kv": nrm(ks[22], (DEPTH, D_MODEL, 2 * MEM_W), D_MODEL ** -0.5),
        "mem_q_norm_g": gain(ks[23], (DEPTH, MEM_HD)),
        "mem_k_norm_g": gain(ks[24], (DEPTH, MEM_HD)),
        "w_br_attn": nrm(ks[25], (DEPTH, MLA_W, D_MODEL), MLA_W ** -0.5),
        "w_br_ssm": nrm(ks[26], (DEPTH, SSM_W, D_MODEL), SSM_W ** -0.5),
        "w_br_mem": nrm(ks[27], (DEPTH, MEM_W, D_MODEL), MEM_W ** -0.5),
        "w_out": nrm(ks[28], (DEPTH, D_MODEL, D_MODEL), D_MODEL ** -0.5),
        "norm_ffn_g": gain(ks[29], (DEPTH, D_MODEL)),
        "w_ffn_gate": nrm(ks[30], (DEPTH, D_MODEL, FF), D_MODEL ** -0.5),
        "w_ffn_up": nrm(ks[31], (DEPTH, D_MODEL, FF), D_MODEL ** -0.5),
        "w_ffn_down": nrm(ks[32], (DEPTH, FF, D_MODEL), FF ** -0.5),
    }


def reference(x_prompt, x_sample, mem_prompt, mem_sample, norm_mix_g, norm_mem_g, w_in, q_lora_norm_g,
              kv_lora_norm_g, w_uq, w_ukv, mla_q_norm_g, mla_k_norm_g, ssm_lambda_re, ssm_lambda_im,
              ssm_log_step, ssm_b_re, ssm_b_im, ssm_c_re, ssm_c_im, ssm_d, ssm_w_glu, w_mem_kv,
              mem_q_norm_g, mem_k_norm_g, w_br_attn, w_br_ssm, w_br_mem, w_out, norm_ffn_g,
              w_ffn_gate, w_ffn_up, w_ffn_down):
    cos_p, sin_p = _rope_tables(x_prompt.shape[1])
    cos_s, sin_s = _rope_tables(x_sample.shape[1])
    y_prompt = x_prompt
    y_sample = x_sample
    for layer in range(DEPTH):
        p = (norm_mix_g[layer], norm_mem_g[layer], w_in[layer], q_lora_norm_g[layer], kv_lora_norm_g[layer],
             w_uq[layer], w_ukv[layer], mla_q_norm_g[layer], mla_k_norm_g[layer],
             ssm_lambda_re[layer], ssm_lambda_im[layer], ssm_log_step[layer], ssm_b_re[layer], ssm_b_im[layer],
             ssm_c_re[layer], ssm_c_im[layer], ssm_d[layer], ssm_w_glu[layer],
             w_mem_kv[layer], mem_q_norm_g[layer], mem_k_norm_g[layer],
             w_br_attn[layer], w_br_ssm[layer], w_br_mem[layer], w_out[layer],
             norm_ffn_g[layer], w_ffn_gate[layer], w_ffn_up[layer], w_ffn_down[layer])
        y_prompt = _layer(y_prompt, mem_prompt, cos_p, sin_p, p)
        y_sample = _layer(y_sample, mem_sample, cos_s, sin_s, p)
    return (y_prompt, y_sample)
```

```cpp
#include <hip/hip_runtime.h>
#include <hip/hip_cooperative_groups.h>
#include <cstdio>
#include <cstdint>
namespace cg = cooperative_groups;

#ifndef SLOW_GEMM
#define SLOW_GEMM 0
#endif
#ifndef SLOW_ATTN
#define SLOW_ATTN 0
#endif
#ifndef PHM
#define PHM 0xFFF
#endif
#ifndef PH5M
#define PH5M 7
#endif
#ifndef PH3M
#define PH3M 15
#endif
#ifndef DUPM
#define DUPM 0
#endif
#ifndef ATT_SCHED
#define ATT_SCHED 0
#endif
#ifndef EXTRA_SYNCS
#define EXTRA_SYNCS 0
#endif
#ifndef SHADOW_ATT
#define SHADOW_ATT 0
#endif
#ifndef ATT_PRIO
#define ATT_PRIO 1
#endif
#ifndef ATT_MAIN
#define ATT_MAIN attn_unit2
#endif
namespace pg8 {
#define PG8_LAS __attribute__((address_space(3)))
typedef unsigned short bf16_t;
typedef short bf16x8 __attribute__((ext_vector_type(8)));
typedef float f32x4 __attribute__((ext_vector_type(4)));
typedef unsigned u32x4 __attribute__((ext_vector_type(4)));
constexpr int BM = 256, BK = 64, HALF = 128, HTB = HALF * BK * 2  , STAGE_BYTES = 8 * HTB, NXCD = 8, WGM = 8;

__host__ __device__ __forceinline__ int lds_byte(int r, int c) { const int st = (r >> 4) * 2 + (c >> 5), rr = r & 15, cc = c & 31, ob = rr * 64 + cc * 2; return st * 1024 + (ob ^ (((ob >> 9) & 1) << 5)); }
__host__ __device__ __forceinline__ void stage_rc(int b, int& R, int& C) { const int st = b / 1024, sb = b % 1024, swz = sb ^ (((sb >> 9) & 1) << 5); R = (st >> 1) * 16 + swz / 64; C = (st & 1) * 32 + (swz % 64) / 2; }
__host__ __device__ __forceinline__ int perm32(int rho) { const int n = rho >> 4, i = rho & 15; return 8 * (i >> 2) + 4 * n + (i & 3); }

struct Unit { int pm, pn; };
struct Gemm { const bf16_t* A; const bf16_t* Bt; int M, N, K, lda, ldb; const bf16_t* hookG = nullptr; };

struct StaticOrder {
    int nM, nN, nwg, G, c;
    __host__ __device__ void init(int M, int N, int G_, int c_) { nM = M / BM; nN = N / BM; nwg = nM * nN; G = G_; c = c_; }
    __host__ __device__ bool next(int i, Unit& u) const {
        const long L = (long)i * G + c; if (L >= nwg) return false;
        int wgid = (int)L; { const int q = nwg / NXCD, r = nwg % NXCD, xcd = wgid % NXCD, off = wgid / NXCD; wgid = (xcd < r ? xcd * (q + 1) : r * (q + 1) + (xcd - r) * q) + off; }
        const int nig = WGM * nN, gid = wgid / nig, fm = gid * WGM, gsz = (nM - fm) < WGM ? (nM - fm) : WGM;
        u.pm = fm + ((wgid % nig) % gsz); u.pn = (wgid % nig) / gsz; return true;
    }
    __device__ __forceinline__ void a_ready(const Unit&) const {}
    __device__ __forceinline__ void done(const Unit&) const {}
};

__device__ __forceinline__ unsigned cvt_pk_bf16(float lo, float hi) { unsigned r; asm volatile("v_cvt_pk_bf16_f32 %0, %1, %2" : "=v"(r) : "v"(lo), "v"(hi)); return r; }
typedef float f32x2 __attribute__((ext_vector_type(2)));

template <class E> __device__ __forceinline__ void run_epi(const E& e, const f32x4 (&acc)[2][2][4][2], const Unit& u, int wr, int wc, int fr, int fq) {
    asm volatile("" : "+v"(fr), "+v"(fq));
#pragma unroll
    for (int ai = 0; ai < 2; ++ai)
#pragma unroll
        for (int m = 0; m < 4; ++m) { const int row = u.pm * BM + ai * HALF + wr * 64 + m * 16 + fr;
#pragma unroll
            for (int bj = 0; bj < 2; ++bj) { const int col = u.pn * BM + bj * HALF + wc * 32 + (E::PERM ? 8 : 4) * fq; e.apply2(row, col, acc[ai][bj][m][0], acc[ai][bj][m][1]); }
            asm volatile("" ::: "memory"); }
}

template <class Epi, class Sched, bool ALIGN_EPI = false, bool SP2 = false, bool HOOK = false>
__device__ __forceinline__ void gemm_phase(PG8_LAS unsigned char* lds, const Gemm g, const Sched& S, const Epi& E) {
    int tid_l = threadIdx.x; asm volatile("" : "+v"(tid_l));
    const int tid = tid_l, wid = __builtin_amdgcn_readfirstlane(tid >> 6), lane = tid & 63, wr = wid >> 2, wc = wid & 3, fr = lane & 15, fq = lane >> 4;
    const int K = g.K, nt = K / BK;
    unsigned voffA[2], voffB[2];
#pragma unroll
    for (int i = 0; i < 2; ++i) { int R, C; stage_rc(tid * 16 + i * 8192, R, C); const int Rb = Epi::PERM ? ((R & ~31) + perm32(R & 31)) : R;
        voffA[i] = (unsigned)(R * g.lda + C) * 2u; voffB[i] = (unsigned)(Rb * g.ldb + C) * 2u; }
    const size_t kstep = (size_t)(BK * 2);
    const size_t hstepA = (size_t)HALF * g.lda * 2, hstepB = (size_t)HALF * g.ldb * 2;
    const size_t tstepA = 2 * hstepA, tstepB = 2 * hstepB;
    const unsigned ldsw = (unsigned)wid * 1024u;
    const int aoff = lds_byte(wr * 64 + fr, fq * 8), boff = lds_byte(wc * 32 + fr, fq * 8);
#define PG8_SA(b, h) (((b) * 2 + (h)) * HTB)
#define PG8_SB(b, h) ((4 + (b) * 2 + (h)) * HTB)
#define PG8_STAGE(bufoff, gbase, voff) do { _Pragma("unroll") for (int _i = 0; _i < 2; ++_i) \
        __builtin_amdgcn_global_load_lds((const unsigned*)((const char*)(gbase) + (voff)[_i]), (PG8_LAS unsigned*)(lds + (bufoff) + ldsw + _i * 8192), 16, 0, 0); } while (0)
#define PG8_LDA(dst, b, h) do { _Pragma("unroll") for (int m = 0; m < 4; ++m) _Pragma("unroll") for (int k = 0; k < 2; ++k) dst[m][k] = *(const PG8_LAS bf16x8*)(lds + PG8_SA(b, h) + aoff + m * 2048 + k * 1024); } while (0)
#define PG8_LDB(dst, b, h) do { _Pragma("unroll") for (int n = 0; n < 2; ++n) _Pragma("unroll") for (int k = 0; k < 2; ++k) dst[n][k] = *(const PG8_LAS bf16x8*)(lds + PG8_SB(b, h) + boff + n * 2048 + k * 1024); } while (0)
#define PG8_MMA(ai, bj, At, Bt) do { __builtin_amdgcn_s_setprio(1); _Pragma("unroll") for (int m = 0; m < 4; ++m) _Pragma("unroll") for (int n = 0; n < 2; ++n) _Pragma("unroll") for (int k = 0; k < 2; ++k) \
        acc[ai][bj][m][n] = __builtin_amdgcn_mfma_f32_16x16x32_bf16(Bt[n][k], At[m][k], acc[ai][bj][m][n], 0, 0, 0); __builtin_amdgcn_s_setprio(0); } while (0)
#define PG8_WAIT_V(n) asm volatile("s_waitcnt vmcnt(" #n ")" ::: "memory")
#define PG8_WAIT_L(n) asm volatile("s_waitcnt lgkmcnt(" #n ")" ::: "memory")
#define PG8_BAR __builtin_amdgcn_s_barrier()
#define PG8_SCHED __builtin_amdgcn_sched_barrier(0)
    Unit cur, nxt; int ui = 0;
    if (!S.next(0, cur)) return;
    f32x4 acc[2][2][4][2];
#pragma unroll
    for (int a = 0; a < 2; ++a)
#pragma unroll
        for (int b = 0; b < 2; ++b)
#pragma unroll
            for (int m = 0; m < 4; ++m)
#pragma unroll
                for (int n = 0; n < 2; ++n) acc[a][b][m][n] = (f32x4){0.f, 0.f, 0.f, 0.f};
    bf16x8 At[4][2], B0[2][2], B1[2][2];
    const char* cA = (const char*)g.A + (size_t)cur.pm * tstepA; const char* cB = (const char*)g.Bt + (size_t)cur.pn * tstepB;
    S.a_ready(cur);
    if constexpr (SP2) {
        PG8_STAGE(PG8_SB(0, 0), cB, voffB); PG8_STAGE(PG8_SB(0, 1), cB + hstepB, voffB); PG8_STAGE(PG8_SA(0, 0), cA, voffA); PG8_STAGE(PG8_SA(0, 1), cA + hstepA, voffA);
        if (wr == 1) PG8_BAR;
        PG8_WAIT_V(2); PG8_BAR;
        PG8_STAGE(PG8_SB(1, 0), cB + kstep, voffB); PG8_STAGE(PG8_SA(1, 0), cA + kstep, voffA); PG8_STAGE(PG8_SB(1, 1), cB + hstepB + kstep, voffB);
        PG8_WAIT_V(6); PG8_BAR;
    } else {
        PG8_STAGE(PG8_SB(0, 0), cB, voffB); PG8_STAGE(PG8_SA(0, 0), cA, voffA); PG8_STAGE(PG8_SB(0, 1), cB + hstepB, voffB); PG8_STAGE(PG8_SA(0, 1), cA + hstepA, voffA);
        if (wr == 1) PG8_BAR;
        PG8_WAIT_V(4); PG8_BAR;
        PG8_STAGE(PG8_SB(1, 0), cB + kstep, voffB); PG8_STAGE(PG8_SA(1, 0), cA + kstep, voffA); PG8_STAGE(PG8_SB(1, 1), cB + hstepB + kstep, voffB);
        PG8_WAIT_V(6); PG8_BAR;
    }
    for (;;) {
        const bool has_next = S.next(ui + 1, nxt);
        const char* nA = has_next ? (const char*)g.A + (size_t)nxt.pm * tstepA : cA; const char* nB = has_next ? (const char*)g.Bt + (size_t)nxt.pn * tstepB : cB;
        for (int t = 0; t < nt; t += 2) {
            if constexpr (HOOK) {
                if (t == 8 || t == 12) {
                    int fr2 = fr, fq2 = fq; asm volatile("" : "+v"(fr2), "+v"(fq2));
                    const int sa = (t == 8) ? 0 : 1024;
#pragma unroll
                    for (int ai = 0; ai < 2; ++ai)
#pragma unroll
                        for (int m = 0; m < 4; ++m) { const int row = cur.pm * BM + ai * HALF + wr * 64 + m * 16 + fr2;
#pragma unroll
                            for (int bj = 0; bj < 2; ++bj) { const int col = cur.pn * BM + bj * HALF + wc * 32 + 8 * fq2;
                                const bf16_t* gp = g.hookG + (size_t)row * 3072 + sa + col;
                                const u32x4 wa = __builtin_nontemporal_load((const u32x4*)gp), wb = __builtin_nontemporal_load((const u32x4*)(gp + 1024));
                                f32x4 r0, r1;
#define PG8_RAT(wa_, wb_, hi_) ((hi_ ? __builtin_bit_cast(float, (wa_) & 0xffff0000u) : __builtin_bit_cast(float, (wa_) << 16)) * __builtin_amdgcn_rcpf(__builtin_fmaxf(hi_ ? __builtin_bit_cast(float, (wb_) & 0xffff0000u) : __builtin_bit_cast(float, (wb_) << 16), 1e-20f)))
                                r0[0] = PG8_RAT(wa.x, wb.x, 0); r0[1] = PG8_RAT(wa.x, wb.x, 1); r0[2] = PG8_RAT(wa.y, wb.y, 0); r0[3] = PG8_RAT(wa.y, wb.y, 1);
                                r1[0] = PG8_RAT(wa.z, wb.z, 0); r1[1] = PG8_RAT(wa.z, wb.z, 1); r1[2] = PG8_RAT(wa.w, wb.w, 0); r1[3] = PG8_RAT(wa.w, wb.w, 1);
#undef PG8_RAT
                                acc[ai][bj][m][0] *= r0; acc[ai][bj][m][1] *= r1; }
                            asm volatile("" ::: "memory"); }
                }
            }
            const bool last = (t == nt - 2);
            const char* a1 = cA + (size_t)(t + 1) * kstep;
            const char* a2 = last ? nA : cA + (size_t)(t + 2) * kstep; const char* b2 = last ? nB : cB + (size_t)(t + 2) * kstep;
            const char* a3 = a2 + kstep; const char* b3 = b2 + kstep;
            if (last && has_next) S.a_ready(nxt);
            if constexpr (SP2) {
            PG8_LDB(B0, 0, 0); PG8_LDB(B1, 0, 1); PG8_SCHED; PG8_LDA(At, 0, 0); PG8_STAGE(PG8_SA(1, 1), a1 + hstepA, voffA);
            PG8_WAIT_V(8); PG8_WAIT_L(0); PG8_BAR; PG8_MMA(0, 0, At, B0); PG8_MMA(0, 1, At, B1); PG8_BAR; PG8_SCHED;
            PG8_LDA(At, 0, 1); PG8_STAGE(PG8_SB(0, 0), b2, voffB); PG8_STAGE(PG8_SB(0, 1), b2 + hstepB, voffB); PG8_STAGE(PG8_SA(0, 0), a2, voffA);
            PG8_WAIT_V(8); PG8_WAIT_L(0); PG8_BAR; PG8_MMA(1, 0, At, B0); PG8_MMA(1, 1, At, B1); PG8_BAR; PG8_SCHED;
            PG8_LDB(B0, 1, 0); PG8_LDB(B1, 1, 1); PG8_SCHED; PG8_LDA(At, 1, 0); PG8_STAGE(PG8_SA(0, 1), a2 + hstepA, voffA);
            PG8_WAIT_V(8); PG8_WAIT_L(0); PG8_BAR; PG8_MMA(0, 0, At, B0); PG8_MMA(0, 1, At, B1); PG8_BAR; PG8_SCHED;
            PG8_LDA(At, 1, 1); PG8_STAGE(PG8_SB(1, 0), b3, voffB); PG8_STAGE(PG8_SB(1, 1), b3 + hstepB, voffB); PG8_STAGE(PG8_SA(1, 0), a3, voffA);
            PG8_WAIT_V(8); PG8_WAIT_L(0); PG8_BAR; PG8_MMA(1, 0, At, B0); PG8_MMA(1, 1, At, B1); PG8_BAR; PG8_SCHED;
            } else {
            PG8_LDB(B0, 0, 0); PG8_SCHED; PG8_LDA(At, 0, 0); PG8_STAGE(PG8_SA(1, 1), a1 + hstepA, voffA);
            PG8_WAIT_L(8); PG8_BAR; PG8_WAIT_L(0); PG8_MMA(0, 0, At, B0); PG8_BAR; PG8_SCHED;
            PG8_LDB(B1, 0, 1); PG8_STAGE(PG8_SB(0, 0), b2, voffB);
            PG8_BAR; PG8_WAIT_L(0); PG8_MMA(0, 1, At, B1); PG8_BAR;
            PG8_LDA(At, 0, 1); PG8_STAGE(PG8_SA(0, 0), a2, voffA);
            PG8_BAR; PG8_WAIT_L(0); PG8_MMA(1, 0, At, B0); PG8_BAR; PG8_SCHED;
            PG8_STAGE(PG8_SB(0, 1), b2 + hstepB, voffB);
            PG8_WAIT_V(6); PG8_BAR; PG8_MMA(1, 1, At, B1); PG8_BAR;
            PG8_LDB(B0, 1, 0); PG8_SCHED; PG8_LDA(At, 1, 0); PG8_STAGE(PG8_SA(0, 1), a2 + hstepA, voffA);
            PG8_WAIT_L(8); PG8_BAR; PG8_WAIT_L(0); PG8_MMA(0, 0, At, B0); PG8_BAR; PG8_SCHED;
            PG8_LDB(B1, 1, 1); PG8_STAGE(PG8_SB(1, 0), b3, voffB);
            PG8_BAR; PG8_WAIT_L(0); PG8_MMA(0, 1, At, B1); PG8_BAR;
            PG8_LDA(At, 1, 1); PG8_STAGE(PG8_SA(1, 0), a3, voffA);
            PG8_BAR; PG8_WAIT_L(0); PG8_MMA(1, 0, At, B0); PG8_BAR; PG8_SCHED;
            PG8_STAGE(PG8_SB(1, 1), b3 + hstepB, voffB);
            PG8_WAIT_V(6); PG8_BAR; PG8_MMA(1, 1, At, B1); PG8_BAR;
            }
        }
        if constexpr (ALIGN_EPI) { if (wr == 0) PG8_BAR; }
        if constexpr (!Epi::AFTER_DRAIN) { run_epi(E, acc, cur, wr, wc, fr, fq); S.done(cur); }
        if (!has_next) break;
#pragma unroll
        for (int a = 0; a < 2; ++a)
#pragma unroll
            for (int b = 0; b < 2; ++b)
#pragma unroll
                for (int m = 0; m < 4; ++m)
#pragma unroll
                    for (int n = 0; n < 2; ++n) acc[a][b][m][n] = (f32x4){0.f, 0.f, 0.f, 0.f};
        cur = nxt; cA = nA; cB = nB; ++ui;
        if constexpr (ALIGN_EPI) { if (wr == 1) PG8_BAR; }
    }
    PG8_WAIT_V(0);
    if constexpr (!ALIGN_EPI) { if (wr == 0) PG8_BAR; }
    PG8_BAR;
    if constexpr (Epi::AFTER_DRAIN) { E.fused(acc, cur, wr, wc, fr, fq, lds, wid, lane); S.done(cur); }
#undef PG8_SA
#undef PG8_SB
#undef PG8_STAGE
#undef PG8_LDA
#undef PG8_LDB
#undef PG8_MMA
#undef PG8_WAIT_V
#undef PG8_WAIT_L
#undef PG8_BAR
#undef PG8_SCHED
}
}

#define GAS __attribute__((address_space(1)))
#define LAS __attribute__((address_space(3)))
typedef unsigned short bf16;
typedef unsigned v4u __attribute__((ext_vector_type(4)));
typedef unsigned v2u __attribute__((ext_vector_type(2)));
typedef float f32x4 __attribute__((ext_vector_type(4)));
typedef float f32x16 __attribute__((ext_vector_type(16)));
typedef short bf16x8 __attribute__((ext_vector_type(8)));

constexpr int NBATCH = 20, NPROMPT = 4, SEQ = 4096, MT = NBATCH * SEQ, DM = 1024;
constexpr int MROWS_P = NPROMPT * SEQ;
constexpr int MEMTOK = 256, MMEM = NBATCH * MEMTOK;
constexpr int NZ = 4352, NZS = 1280, NG = 3072, FFD = 2816;
constexpr float EPS = 1e-6f, LOG2E = 1.4426950408889634f;
constexpr float QSCALE = 0.10206207261596575f * LOG2E;
constexpr float MQSCALE = 0.125f * LOG2E;
constexpr int NWAVES = 8, NTHR = 512;
constexpr int CH = 64, NCHUNK = SEQ / CH, SROWS = NBATCH * NCHUNK;
constexpr int ULD = 1280;

constexpr size_t MiB = 1u << 20;
constexpr size_t WS_WIN = 0;
constexpr size_t WS_WUQ = WS_WIN + (size_t)NZ * 1024 * 2;
constexpr size_t WS_WUKV = WS_WUQ + (size_t)768 * 384 * 2;
constexpr size_t WS_WGLU = WS_WUKV + (size_t)1024 * 256 * 2;
constexpr size_t WS_WMKV = WS_WGLU + (size_t)256 * 256 * 2;
constexpr size_t WS_WB = WS_WMKV + (size_t)512 * 1024 * 2;
constexpr size_t WS_WOUT = WS_WB + (size_t)1024 * 1024 * 2;
constexpr size_t WS_WGU = WS_WOUT + (size_t)1024 * 1024 * 2;
constexpr size_t WS_WD = WS_WGU + (size_t)5632 * 1024 * 2;
constexpr size_t WS_WEND = WS_WD + (size_t)1024 * 2816 * 2;
static_assert(WS_WEND <= 40 * MiB, "weights");
constexpr size_t WS_BTY = 40 * MiB;
constexpr size_t WS_BST = 80 * MiB;
constexpr size_t WS_SM = 88 * MiB;
constexpr size_t WS_RQ = WS_SM;
constexpr size_t WS_RKV = WS_RQ + (size_t)MT * 4;
constexpr size_t WS_MK = WS_RKV + (size_t)MT * 4;
constexpr size_t WS_MVT = WS_MK + (size_t)MMEM * 256 * 2;
constexpr size_t WS_KLAG = WS_MVT + (size_t)MMEM * 256 * 2;
static_assert(WS_KLAG + 2 * MiB <= 100 * MiB, "small");
constexpr size_t WS_MQ = 100 * MiB;
constexpr size_t WS_URE = 140 * MiB;
constexpr size_t WS_SST = 190 * MiB;
constexpr size_t WS_MERGED = 40 * MiB;
constexpr size_t WS_ZS = 210 * MiB;
constexpr size_t WS_OB = WS_ZS;
constexpr size_t WS_YACT = WS_ZS + 160 * MiB;
constexpr size_t WS_H2 = WS_ZS;
constexpr size_t WS_G = 410 * MiB;
constexpr size_t WS_ACT = WS_G;
constexpr size_t WS_BAR = 890 * MiB;
constexpr size_t WS_RSS = 890 * MiB + 65536;
constexpr size_t WS_END = 891 * MiB;
constexpr size_t DO_XN = 0;
constexpr size_t DO_MEMN = 160 * MiB;
constexpr size_t DO_QF = 0;
constexpr size_t DO_KF = 120 * MiB;
constexpr size_t DO_VT = 240 * MiB;

constexpr int LDS_BYTES = 147456;

#define LDS_WAIT() asm volatile("s_waitcnt lgkmcnt(0)" ::: "memory")
__device__ __forceinline__ unsigned f2bf(float f) { unsigned u = __builtin_bit_cast(unsigned, f); return (u + 0x7fffu + ((u >> 16) & 1u)) >> 16; }
typedef float f32x2_t __attribute__((ext_vector_type(2))); typedef __bf16 bf16x2_t __attribute__((ext_vector_type(2)));
__device__ __forceinline__ unsigned pk2(float lo, float hi) { f32x2_t v = {lo, hi}; bf16x2_t b = __builtin_convertvector(v, bf16x2_t); return __builtin_bit_cast(unsigned, b); }
__device__ __forceinline__ float bflo(unsigned w) { return __builtin_bit_cast(float, w << 16); }
__device__ __forceinline__ float bfhi(unsigned w) { return __builtin_bit_cast(float, w & 0xffff0000u); }
__device__ __forceinline__ float wave_sum(float v) {
#pragma unroll
    for (int o = 1; o < 64; o <<= 1) v += __shfl_xor(v, o);
    return v;
}
__device__ __forceinline__ float sumsq8(v4u p) {
    float a = bflo(p.x), b = bfhi(p.x), c = bflo(p.y), d = bfhi(p.y), e = bflo(p.z), f = bfhi(p.z), g = bflo(p.w), h = bfhi(p.w);
    return ((a * a + b * b) + (c * c + d * d)) + ((e * e + f * f) + (g * g + h * h));
}
__device__ __forceinline__ float sigmoidf_(float x) { return __builtin_amdgcn_rcpf(1.0f + __builtin_amdgcn_exp2f(-1.4426950408889634f * x)); }
__device__ __forceinline__ float gelu_tanh(float x) { const float u = 1.5957691216057308f * (x + 0.044715f * x * x * x); return x * __builtin_amdgcn_rcpf(1.0f + __builtin_amdgcn_exp2f(-1.4426950408889634f * u)); }
__device__ __forceinline__ const float* xrow_ptr(const float* xp, const float* xs, int m) { return m < MROWS_P ? xp + (size_t)m * DM : xs + (size_t)(m - MROWS_P) * DM; }

__device__ __forceinline__ void cpowk(float lre, float lim, float dt, int k, float& pr, float& pi) {
    const float mag = expf((float)k * lre * dt);
    double rev = (double)k * (double)lim * (double)dt * 0.15915494309189535;
    rev -= floor(rev);
    const float fr = (float)rev;
    pr = mag * __builtin_amdgcn_cosf(fr); pi = mag * __builtin_amdgcn_sinf(fr);
}
__device__ __forceinline__ void zcoef(float lre, float lim, float dt, float& zr, float& zi) {
    float ar, ai; cpowk(lre, lim, dt, 1, ar, ai);
    const float den = lre * lre + lim * lim, nre = ar - 1.0f;
    zr = (nre * lre + ai * lim) / den; zi = (ai * lre - nre * lim) / den;
}

template <class Epi, class Sched>
__device__ __forceinline__ void run_gemm(LAS unsigned char* lds, const pg8::Gemm g, const Sched& S, const Epi& E) {
    pg8::gemm_phase<Epi, Sched, true, true>(lds, g, S, E);
}
template <class Epi, class Sched>
__device__ __forceinline__ void run_gemm_hook(LAS unsigned char* lds, const pg8::Gemm g, const Sched& S, const Epi& E) {
    pg8::gemm_phase<Epi, Sched, true, true, true>(lds, g, S, E);
}
template <class Epi, class Sched>
__device__ __forceinline__ void run_gemm4(LAS unsigned char* lds, const pg8::Gemm g, const Sched& S, const Epi& E) {
    pg8::gemm_phase<Epi, Sched, true, false>(lds, g, S, E);
}

struct BatchedOrder {
    int npg, G, c;
    __device__ bool next(int i, pg8::Unit& u) const {
        const int L = i * G + c; if (L >= 80 * npg) return false;
        u.pm = L / npg; u.pn = (u.pm / 5) * npg + (L % npg); return true;
    }
    __device__ __forceinline__ void a_ready(const pg8::Unit&) const {}
    __device__ __forceinline__ void done(const pg8::Unit&) const {}
};

#define EPI_FLAGS static constexpr bool PERM = true, AFTER_DRAIN = false;
__device__ __forceinline__ void st_bf8(bf16* p, f32x4 a, f32x4 b) { v4u w; w.x = pk2(a[0], a[1]); w.y = pk2(a[2], a[3]); w.z = pk2(b[0], b[1]); w.w = pk2(b[2], b[3]); *(v4u*)p = w; }
__device__ __forceinline__ void st_bf8_nt(bf16* p, f32x4 a, f32x4 b) { v4u w; w.x = pk2(a[0], a[1]); w.y = pk2(a[2], a[3]); w.z = pk2(b[0], b[1]); w.w = pk2(b[2], b[3]); __builtin_nontemporal_store(w, (v4u*)p); }
__device__ __forceinline__ void st_bf4(bf16* p, f32x4 v) { v2u w; w.x = pk2(v[0], v[1]); w.y = pk2(v[2], v[3]); *(v2u*)p = w; }
__device__ __forceinline__ void ld_bf8(const bf16* p, f32x4& a, f32x4& b) { const v4u w = *(const v4u*)p; a = (f32x4){bflo(w.x), bfhi(w.x), bflo(w.y), bfhi(w.y)}; b = (f32x4){bflo(w.z), bfhi(w.z), bflo(w.w), bfhi(w.w)}; }
__device__ __forceinline__ void ld_bf8_nt(const bf16* p, f32x4& a, f32x4& b) { const v4u w = __builtin_nontemporal_load((const v4u*)p); a = (f32x4){bflo(w.x), bfhi(w.x), bflo(w.y), bfhi(w.y)}; b = (f32x4){bflo(w.z), bfhi(w.z), bflo(w.w), bfhi(w.w)}; }
__device__ __forceinline__ f32x4 sig4(f32x4 v) { f32x4 s; s[0] = sigmoidf_(v[0]); s[1] = sigmoidf_(v[1]); s[2] = sigmoidf_(v[2]); s[3] = sigmoidf_(v[3]); return s; }

struct EpiZ { EPI_FLAGS bf16* Zs; bf16* G;
    __device__ __forceinline__ void apply2(int row, int col, f32x4 v0, f32x4 v1) const {
        if (col < NZS) st_bf8(Zs + (size_t)row * NZS + col, v0, v1);
        else st_bf8_nt(G + (size_t)row * NG + (col - NZS), sig4(v0), sig4(v1)); } };

struct EpiStore { EPI_FLAGS bf16* O; int ld;
    __device__ __forceinline__ void apply2(int row, int col, f32x4 v0, f32x4 v1) const { st_bf8(O + (size_t)row * ld + col, v0, v1); } };

struct EpiRowScale { EPI_FLAGS bf16* O; int ld; const float* rs;
    __device__ __forceinline__ void apply2(int row, int col, f32x4 v0, f32x4 v1) const { const float r = rs[row]; st_bf8(O + (size_t)row * ld + col, v0 * r, v1 * r); } };

struct EpiKnope { EPI_FLAGS bf16* Kf;
    __device__ __forceinline__ void apply2(int row, int col, f32x4 v0, f32x4 v1) const { const int c0 = (col >> 6) * 96 + (col & 63);
        st_bf8(Kf + (size_t)row * 768 + c0, v0, v1); } };

struct EpiColScale { EPI_FLAGS bf16* O; int ld; const float* cs;
    __device__ __forceinline__ void apply2(int row, int col, f32x4 v0, f32x4 v1) const {
        const f32x4 s0 = *(const f32x4*)(cs + col), s1 = *(const f32x4*)(cs + col + 4);
        st_bf8(O + (size_t)row * ld + col, v0 * s0, v1 * s1); } };

struct EpiSst { EPI_FLAGS float* S;
    __device__ __forceinline__ void apply2(int row, int col, f32x4 v0, f32x4 v1) const { const int c = col & 255; *(f32x4*)(S + (size_t)row * 256 + c) = v0; *(f32x4*)(S + (size_t)row * 256 + c + 4) = v1; } };

struct EpiY { EPI_FLAGS const bf16* Ure; const float* dvec; bf16* Yact;
    __device__ __forceinline__ void apply2(int row, int colg, f32x4 v0, f32x4 v1) const {
        const int g = row / SROWS, col = colg & 1023, t = col >> 4, h0 = col & 15;
        const int m = (row - g * SROWS) * CH + t, ch = g * 16 + h0;
        f32x4 u0, u1; ld_bf8(Ure + (size_t)row * ULD + col, u0, u1);
        const f32x4 d0 = *(const f32x4*)(dvec + ch), d1 = *(const f32x4*)(dvec + ch + 4);
        f32x4 y0 = v0 + d0 * u0, y1 = v1 + d1 * u1;
        y0[0] = gelu_tanh(y0[0]); y0[1] = gelu_tanh(y0[1]); y0[2] = gelu_tanh(y0[2]); y0[3] = gelu_tanh(y0[3]);
        y1[0] = gelu_tanh(y1[0]); y1[1] = gelu_tanh(y1[1]); y1[2] = gelu_tanh(y1[2]); y1[3] = gelu_tanh(y1[3]);
        st_bf8(Yact + (size_t)m * 256 + ch, y0, y1); } };

struct EpiGlu { EPI_FLAGS const bf16* Yact; bf16* Ossm; int ld;
    __device__ __forceinline__ void apply2(int row, int col, f32x4 v0, f32x4 v1) const { f32x4 y0, y1; ld_bf8(Yact + (size_t)row * 256 + col, y0, y1);
        st_bf8(Ossm + (size_t)row * ld + col, y0 * sig4(v0), y1 * sig4(v1)); } };

struct EpiBranchF { EPI_FLAGS const bf16* G; bf16* Mg;
    __device__ __forceinline__ void apply2(int row, int col, f32x4 v0, f32x4 v1) const { f32x4 g0, g1; ld_bf8_nt(G + (size_t)row * NG + 2048 + col, g0, g1);
        st_bf8(Mg + (size_t)row * 1024 + col, g0 * v0, g1 * v1); } };

struct EpiOut { EPI_FLAGS const float* xp; const float* xs; float* out; bf16* X1b; float* rss;
    __device__ __forceinline__ void apply2(int row, int col, f32x4 v0, f32x4 v1) const { const float* xr = xrow_ptr(xp, xs, row) + col; float* o = out + (size_t)row * DM + col;
        const f32x4 a0 = __builtin_nontemporal_load((const f32x4*)xr) + v0, a1 = __builtin_nontemporal_load((const f32x4*)(xr + 4)) + v1;
        *(f32x4*)o = a0; *(f32x4*)(o + 4) = a1; st_bf8(X1b + (size_t)row * DM + col, a0, a1);
        float ss = ((a0[0] * a0[0] + a0[1] * a0[1]) + (a0[2] * a0[2] + a0[3] * a0[3])) + ((a1[0] * a1[0] + a1[1] * a1[1]) + (a1[2] * a1[2] + a1[3] * a1[3]));
        ss += __shfl_xor(ss, 16); ss += __shfl_xor(ss, 32);
        if (((threadIdx.x >> 4) & 3) == 0) unsafeAtomicAdd(rss + row, ss); } };

struct EpiSwiglu { EPI_FLAGS bf16* Act; const float* rss;
    __device__ __forceinline__ void apply2(int row, int col, f32x4 v0, f32x4 v1) const { const int c = col >> 1; const float r = 1.0f / sqrtf(rss[row] * (1.f / DM) + EPS);
        const f32x4 gt = v0 * r, up = v1 * r;
        st_bf4(Act + (size_t)row * FFD + c, gt * sig4(gt) * up); } };

struct EpiDown { EPI_FLAGS float* out;
    __device__ __forceinline__ void apply2(int row, int col, f32x4 v0, f32x4 v1) const { float* o = out + (size_t)row * DM + col; *(f32x4*)o = *(const f32x4*)o + v0; *(f32x4*)(o + 4) = *(const f32x4*)(o + 4) + v1; } };

template <class RowMap>
__device__ __forceinline__ void transpose_item(const float* W, int K, int N, bf16* WT, int ldw, const RowMap rm, const float* kscale, LAS float* scr, int item, int lane) {
    const int nblk = N / 32, kb = item / nblk, nb = item % nblk, k0 = 64 * kb, n0 = 32 * nb;
    float wv[32];
#pragma unroll
    for (int i = 0; i < 32; ++i) wv[i] = W[(size_t)(k0 + 2 * i + (lane >> 5)) * N + n0 + (lane & 31)];
#pragma unroll
    for (int i = 0; i < 32; ++i) { const int kk = 2 * i + (lane >> 5); float v = wv[i]; if (kscale) v *= kscale[k0 + kk]; scr[kk * 33 + (lane & 31)] = v; }
    LDS_WAIT(); asm volatile("" ::: "memory");
    const int c = lane & 7;
#pragma unroll
    for (int j = 0; j < 4; ++j) { const int n = (lane >> 3) + 8 * j; const LAS float* s = scr + (8 * c) * 33 + n;
        v4u o; o.x = pk2(s[0 * 33], s[1 * 33]); o.y = pk2(s[2 * 33], s[3 * 33]); o.z = pk2(s[4 * 33], s[5 * 33]); o.w = pk2(s[6 * 33], s[7 * 33]);
        *(v4u*)(WT + (size_t)rm(n0 + n) * ldw + k0 + 8 * c) = o; }
    LDS_WAIT(); asm volatile("" ::: "memory");
}
struct RmId { __device__ __forceinline__ int operator()(int n) const { return n; } };
struct RmWin { __device__ __forceinline__ int operator()(int n) const { return n < 672 ? n : n + 96; } };
struct RmUkv { __device__ __forceinline__ int operator()(int n) const { const int h = n >> 7, r = n & 127; return (r < 64 ? 0 : 512) + h * 64 + (r & 63); } };
struct RmGate { __device__ __forceinline__ int operator()(int n) const { return 8 * (n >> 2) + (n & 3); } };
struct RmUp { __device__ __forceinline__ int operator()(int n) const { return 8 * (n >> 2) + 4 + (n & 3); } };

__device__ __forceinline__ void rms_row_to_bf16(const float* xrow, const float* gain, bf16* orow, int lane) {
    const f32x4* xr = (const f32x4*)xrow + lane; const f32x4* gr = (const f32x4*)gain + lane;
    f32x4 v[4]; float s = 0.f;
#pragma unroll
    for (int j = 0; j < 4; ++j) { v[j] = xr[64 * j]; s += (v[j].x * v[j].x + v[j].y * v[j].y) + (v[j].z * v[j].z + v[j].w * v[j].w); }
    const float rstd = 1.0f / sqrtf(wave_sum(s) * (1.f / DM) + EPS);
    unsigned long long* o8 = (unsigned long long*)orow + lane;
#pragma unroll
    for (int j = 0; j < 4; ++j) { const f32x4 gg = gr[64 * j]; o8[64 * j] = (unsigned long long)pk2(v[j].x * rstd * gg.x, v[j].y * rstd * gg.y) | ((unsigned long long)pk2(v[j].z * rstd * gg.z, v[j].w * rstd * gg.w) << 32); }
}

__device__ __forceinline__ void rms_rows2_to_bf16(const float* xrow0, const float* xrow1, const float* gain, bf16* orow0, bf16* orow1, int lane) {
    const f32x4* xr0 = (const f32x4*)xrow0 + lane; const f32x4* xr1 = (const f32x4*)xrow1 + lane; const f32x4* gr = (const f32x4*)gain + lane;
    f32x4 v0[4], v1[4]; float s0 = 0.f, s1 = 0.f;
#pragma unroll
    for (int j = 0; j < 4; ++j) { v0[j] = xr0[64 * j]; v1[j] = xr1[64 * j]; }
#pragma unroll
    for (int j = 0; j < 4; ++j) { s0 += (v0[j].x * v0[j].x + v0[j].y * v0[j].y) + (v0[j].z * v0[j].z + v0[j].w * v0[j].w); s1 += (v1[j].x * v1[j].x + v1[j].y * v1[j].y) + (v1[j].z * v1[j].z + v1[j].w * v1[j].w); }
    const float r0 = 1.0f / sqrtf(wave_sum(s0) * (1.f / DM) + EPS), r1 = 1.0f / sqrtf(wave_sum(s1) * (1.f / DM) + EPS);
    unsigned long long* o0 = (unsigned long long*)orow0 + lane; unsigned long long* o1 = (unsigned long long*)orow1 + lane;
#pragma unroll
    for (int j = 0; j < 4; ++j) { const f32x4 gg = gr[64 * j];
        o0[64 * j] = (unsigned long long)pk2(v0[j].x * r0 * gg.x, v0[j].y * r0 * gg.y) | ((unsigned long long)pk2(v0[j].z * r0 * gg.z, v0[j].w * r0 * gg.w) << 32);
        o1[64 * j] = (unsigned long long)pk2(v1[j].x * r1 * gg.x, v1[j].y * r1 * gg.y) | ((unsigned long long)pk2(v1[j].z * r1 * gg.z, v1[j].w * r1 * gg.w) << 32); }
}

__device__ const double kRopeRev[16] = {
    0.15915494309189535, 0.08949959670338732, 0.05032921210448704, 0.028302217328425758,
    0.015915494309189534, 0.008949959670338732, 0.005032921210448704, 0.0028302217328425756,
    0.0015915494309189536, 0.0008949959670338732, 0.0005032921210448704, 0.00028302217328425755,
    0.00015915494309189535, 8.949959670338732e-05, 5.032921210448704e-05, 2.8302217328425757e-05 };

__device__ __forceinline__ v4u scale_piece(v4u p, float r, const float* gp) {
    const f32x4 g0 = *(const f32x4*)gp, g1 = *(const f32x4*)(gp + 4); v4u o;
    o.x = pk2(bflo(p.x) * r * g0[0], bfhi(p.x) * r * g0[1]); o.y = pk2(bflo(p.y) * r * g0[2], bfhi(p.y) * r * g0[3]);
    o.z = pk2(bflo(p.z) * r * g1[0], bfhi(p.z) * r * g1[1]); o.w = pk2(bflo(p.w) * r * g1[2], bfhi(p.w) * r * g1[3]); return o;
}
__device__ __forceinline__ void rope_pair(unsigned& w1, unsigned& w2, float r, float scale, const float* g1p, const float* g2p, int pos, int j) {
    float a0 = bflo(w1) * r * g1p[0], a1 = bfhi(w1) * r * g1p[1], b0 = bflo(w2) * r * g2p[0], b1 = bfhi(w2) * r * g2p[1];
    double rev0 = (double)pos * kRopeRev[j]; rev0 -= floor(rev0); const float f0 = (float)rev0;
    double rev1 = (double)pos * kRopeRev[j + 1]; rev1 -= floor(rev1); const float f1 = (float)rev1;
    const float c0 = __builtin_amdgcn_cosf(f0), s0 = __builtin_amdgcn_sinf(f0), c1 = __builtin_amdgcn_cosf(f1), s1 = __builtin_amdgcn_sinf(f1);
    w1 = pk2((a0 * c0 - b0 * s0) * scale, (a1 * c1 - b1 * s1) * scale);
    w2 = pk2((a0 * s0 + b0 * c0) * scale, (a1 * s1 + b1 * c1) * scale);
}
__device__ __forceinline__ void head96_norm_rope(v4u (&pc)[12], const float* gain, int pos, float scale) {
    float ss = 0.f;
#pragma unroll
    for (int i = 0; i < 12; ++i) ss += sumsq8(pc[i]);
    const float r = 1.0f / sqrtf(ss * (1.f / 96.f) + EPS);
    const float rs = r * scale;
#pragma unroll
    for (int i = 0; i < 8; ++i) { pc[i] = scale_piece(pc[i], rs, gain + 8 * i); asm volatile("" ::: "memory"); }
#pragma unroll
    for (int h2 = 0; h2 < 2; ++h2) {
        { unsigned w1_ = pc[8 + h2].x, w2_ = pc[10 + h2].x; rope_pair(w1_, w2_, r, scale, gain + 64 + 8 * h2 + 0, gain + 80 + 8 * h2 + 0, pos, 8 * h2 + 0); pc[8 + h2].x = w1_; pc[10 + h2].x = w2_; }
        { unsigned w1_ = pc[8 + h2].y, w2_ = pc[10 + h2].y; rope_pair(w1_, w2_, r, scale, gain + 64 + 8 * h2 + 2, gain + 80 + 8 * h2 + 2, pos, 8 * h2 + 2); pc[8 + h2].y = w1_; pc[10 + h2].y = w2_; }
        { unsigned w1_ = pc[8 + h2].z, w2_ = pc[10 + h2].z; rope_pair(w1_, w2_, r, scale, gain + 64 + 8 * h2 + 4, gain + 80 + 8 * h2 + 4, pos, 8 * h2 + 4); pc[8 + h2].z = w1_; pc[10 + h2].z = w2_; }
        { unsigned w1_ = pc[8 + h2].w, w2_ = pc[10 + h2].w; rope_pair(w1_, w2_, r, scale, gain + 64 + 8 * h2 + 6, gain + 80 + 8 * h2 + 6, pos, 8 * h2 + 6); pc[8 + h2].w = w1_; pc[10 + h2].w = w2_; }
        asm volatile("" ::: "memory");
    }
}

typedef unsigned gu32_plain;
#define XB_TMO      128
#define XB_XCNT(j)  (256  + 64 * (j))
#define XB_XSUB(j)  (1280 + 64 * (j))
#define XB_XGEN(j)  (2304 + 64 * (j))
#define XB_TOP      3328
#define XB_TOPGEN   3392
#define XCD_BAR_WORDS 3456
#define XB_SPIN_CAP (1u << 24)

__device__ __forceinline__ unsigned xb_ld(unsigned* p)              { return __hip_atomic_load(p, __ATOMIC_RELAXED, __HIP_MEMORY_SCOPE_AGENT); }
__device__ __forceinline__ unsigned xb_add(unsigned* p, unsigned v) { return __hip_atomic_fetch_add(p, v, __ATOMIC_RELAXED, __HIP_MEMORY_SCOPE_AGENT); }
__device__ __forceinline__ unsigned xb_xcc_id() { return (unsigned)__builtin_amdgcn_s_getreg((3 << 11) | 20) & 0xFu; }
#define XB_SPIN(cond, bar) do { unsigned _sp = 0; while (cond) { __builtin_amdgcn_s_sleep(1); \
    if ((++_sp & 255u) == 0u) { if (xb_ld(&(bar)[XB_TMO])) break; if (_sp > XB_SPIN_CAP) { atomicAdd(&(bar)[XB_TMO], 1u); break; } } } } while (0)

struct XcdBarrier {
    unsigned* bar; unsigned x;
    volatile LAS unsigned* st;
};

__device__ __forceinline__ XcdBarrier xcd_barrier_post(unsigned* bar, volatile LAS unsigned* st) {
    XcdBarrier b; b.bar = bar; b.x = xb_xcc_id(); b.st = st;
    if (threadIdx.x == 0) (void)xb_add(&bar[XB_XCNT(b.x)], 1u);
    return b;
}
__device__ __forceinline__ void xcd_barrier_complete(unsigned* bar, unsigned x, unsigned& nloc, unsigned& nx) {
    const unsigned G = gridDim.x * gridDim.y * gridDim.z;
    unsigned sum, cnt, mine, sp = 0u;
    for (;;) {
        sum = 0u; cnt = 0u; mine = 0u;
#pragma unroll
        for (unsigned j = 0; j < 16; ++j) { const unsigned c = xb_ld(&bar[XB_XCNT(j)]); sum += c; cnt += (c > 0u) ? 1u : 0u; mine = (j == x) ? c : mine; }
        if (sum == G) break;
        __builtin_amdgcn_s_sleep(1);
        if ((++sp & 255u) == 0u) { if (xb_ld(&bar[XB_TMO])) break; if (sp > XB_SPIN_CAP) { atomicAdd(&bar[XB_TMO], 1u); break; } }
    }
    nloc = mine > 0u ? mine : 1u; nx = cnt > 0u ? cnt : 1u;
}

__device__ __forceinline__ void xcd_barrier(const XcdBarrier& b) {
    asm volatile("s_waitcnt vmcnt(0)" ::: "memory");
    __syncthreads();
    if (threadIdx.x == 0) {
        unsigned* bar = b.bar;
        __builtin_amdgcn_s_waitcnt(0);
        unsigned nloc = b.st[0], nx = b.st[1];
        if (nloc == 0u) { xcd_barrier_complete(bar, b.x, nloc, nx); b.st[0] = nloc; b.st[1] = nx; }
        const unsigned old = xb_add(&bar[XB_XSUB(b.x)], 1u);
        const unsigned gen = old / nloc;
        if (old + 1u == (gen + 1u) * nloc) {
            __builtin_amdgcn_fence(__ATOMIC_RELEASE, "agent");
            asm volatile("s_waitcnt vmcnt(0)" ::: "memory");
            const unsigned og = xb_add(&bar[XB_TOP], 1u);
            const unsigned tg = og / nx;
            if (og + 1u == (tg + 1u) * nx) xb_add(&bar[XB_TOPGEN], 1u);
            else XB_SPIN(xb_ld(&bar[XB_TOPGEN]) == tg, bar);
            __builtin_amdgcn_fence(__ATOMIC_ACQUIRE, "agent");
            xb_add(&bar[XB_XGEN(b.x)], 1u);
            asm volatile("s_waitcnt vmcnt(0)" ::: "memory");
        } else {
            XB_SPIN(xb_ld(&bar[XB_XGEN(b.x)]) == gen, bar);
            __builtin_amdgcn_fence(__ATOMIC_ACQUIRE, "agent");
            asm volatile("s_waitcnt vmcnt(0)" ::: "memory");
        }
    }
    __syncthreads();
}

constexpr int VT_PITCH = 144;
template <int DK>
__device__ __forceinline__ void attn_unit(LAS unsigned char* lds, const bf16* __restrict__ Q, int q_ld, const bf16* __restrict__ K, int k_ld,
                                          const bf16* __restrict__ VT, int vt_ld, int nkeys, bf16* __restrict__ O, int o_ld) {
    constexpr int NCH = DK / 8, NDS = DK / 16, KBYTES = NCH * 1024, VBYTES = 64 * VT_PITCH, BUFB = KBYTES + VBYTES;
    int tid_l = threadIdx.x; asm volatile("" : "+v"(tid_l));
    const int tid = tid_l, lane = tid & 63, wid = tid >> 6, q = lane & 31, hi = lane >> 5;
    const int NT = nkeys / 64;
#if SLOW_ATTN
    LAS float* Ks = (LAS float*)lds;
    LAS float* Vs = Ks + 64 * (DK + 1);
    constexpr int DS = DK / 8;
    const int sub = tid & 7, qi = tid >> 3;
    for (int pass = 0; pass < 4; ++pass) {
        const int row = pass * 64 + qi;
        float qv[DS], o[8], m = -1e30f, l = 0.f;
#pragma unroll
        for (int i = 0; i < DS; ++i) { const unsigned short w = Q[(size_t)row * q_ld + sub * DS + i]; qv[i] = __builtin_bit_cast(float, (unsigned)w << 16); }
#pragma unroll
        for (int i = 0; i < 8; ++i) o[i] = 0.f;
        for (int t = 0; t < NT; ++t) {
            __syncthreads();
            for (int idx = tid; idx < 64 * DK; idx += NTHR) { const int key = idx / DK, d = idx % DK; Ks[key * (DK + 1) + d] = __builtin_bit_cast(float, (unsigned)K[(size_t)(t * 64 + key) * k_ld + d] << 16); }
            for (int idx = tid; idx < 64 * 64; idx += NTHR) { const int d = idx >> 6, key = idx & 63; Vs[d * 65 + key] = __builtin_bit_cast(float, (unsigned)VT[(size_t)d * vt_ld + t * 64 + key] << 16); }
            __syncthreads();
            for (int key = 0; key < 64; ++key) {
                float part = 0.f;
#pragma unroll
                for (int i = 0; i < DS; ++i) part += qv[i] * Ks[key * (DK + 1) + sub * DS + i];
                part += __shfl_xor(part, 1); part += __shfl_xor(part, 2); part += __shfl_xor(part, 4);
                const float mn = fmaxf(m, part), al = exp2f(m - mn), p = exp2f(part - mn);
                l = l * al + p; m = mn;
#pragma unroll
                for (int i = 0; i < 8; ++i) o[i] = o[i] * al + p * Vs[(8 * sub + i) * 65 + key];
            }
        }
        const float inv = 1.0f / l;
        v4u w; w.x = pk2(o[0] * inv, o[1] * inv); w.y = pk2(o[2] * inv, o[3] * inv); w.z = pk2(o[4] * inv, o[5] * inv); w.w = pk2(o[6] * inv, o[7] * inv);
        *(v4u*)(O + (size_t)row * o_ld + 8 * sub) = w;
    }
    __syncthreads();
#else
    bf16x8 qf[NDS];
    { const bf16* qp = Q + (size_t)(32 * wid + q) * q_ld + 8 * hi;
#pragma unroll
      for (int ds = 0; ds < NDS; ++ds) qf[ds] = *(const bf16x8*)(qp + 16 * ds); }
    constexpr int KP = NCH * 64;
    const int k0key = tid / NCH, k0c = tid % NCH;
    const int k1idx = tid + NTHR, k1key = k1idx / NCH, k1c = k1idx % NCH;
    const bool has_k1 = (k1idx < KP);
    const int vd = tid >> 3, vpc = tid & 7;
    const bf16* kg0 = K + (size_t)k0key * k_ld + k0c * 8;
    const bf16* kg1 = K + (size_t)(has_k1 ? k1key : 0) * k_ld + (has_k1 ? k1c : 0) * 8;
    const bf16* vg = VT + (size_t)vd * vt_ld + vpc * 8;
    const int kl0 = k0c * 1024 + (k0key ^ k0c) * 16, kl1 = k1c * 1024 + (k1key ^ k1c) * 16, vl = KBYTES + vd * VT_PITCH + (vpc >> 1) * 32 + (vpc & 1) * 8;
    v4u rk0, rv;
    rk0 = *(const v4u*)kg0; rv = *(const v4u*)vg;
    __syncthreads();
    *(LAS v4u*)(lds + kl0) = rk0; if (has_k1) { const v4u t1_ = *(const v4u*)kg1; *(LAS v4u*)(lds + kl1) = t1_; } *(LAS v2u*)(lds + vl) = (v2u){rv.x, rv.y}; *(LAS v2u*)(lds + vl + 16) = (v2u){rv.z, rv.w};
    __syncthreads();
    f32x16 o0 = {}, o1 = {};
    float mrun = -1e30f, lrun = 0.f;
    if (__builtin_amdgcn_readfirstlane(tid) >= 256) __builtin_amdgcn_s_setprio(1);
#pragma unroll 1
    for (int t = 0; t < NT; ++t) {
        LAS unsigned char* buf = lds + (t & 1) * BUFB;
        LAS unsigned char* nbuf = lds + ((t + 1) & 1) * BUFB;
        const bool pre = (t + 1 < NT);
        if (pre) { const size_t ko = (size_t)(t + 1) * 64 * k_ld; rk0 = *(const v4u*)(kg0 + ko); rv = *(const v4u*)(vg + (size_t)(t + 1) * 64); }
        f32x16 s0 = {}, s1 = {};
#pragma unroll
        for (int ds = 0; ds < NDS; ++ds) {
            const bf16x8 a0 = *(const LAS bf16x8*)(buf + (2 * ds + hi) * 1024 + (q ^ (2 * ds + hi)) * 16);
            const bf16x8 a1 = *(const LAS bf16x8*)(buf + (2 * ds + hi) * 1024 + ((32 + q) ^ (2 * ds + hi)) * 16);
            s0 = __builtin_amdgcn_mfma_f32_32x32x16_bf16(a0, qf[ds], s0, 0, 0, 0);
            s1 = __builtin_amdgcn_mfma_f32_32x32x16_bf16(a1, qf[ds], s1, 0, 0, 0);
        }
        float mx = s0[0];
#pragma unroll
        for (int r = 0; r < 16; ++r) { mx = fmaxf(mx, s0[r]); mx = fmaxf(mx, s1[r]); }
        mx = fmaxf(mx, __shfl_xor(mx, 32));
        if (__any(mx > mrun + 8.0f)) {
            const float mn = fmaxf(mrun, mx), al = __builtin_amdgcn_exp2f(mrun - mn);
            mrun = mn; lrun *= al;
#pragma unroll
            for (int r = 0; r < 16; ++r) { o0[r] *= al; o1[r] *= al; }
        }
        float ps = 0.f;
#pragma unroll
        for (int r = 0; r < 16; ++r) { s0[r] = __builtin_amdgcn_exp2f(s0[r] - mrun); s1[r] = __builtin_amdgcn_exp2f(s1[r] - mrun); ps += s0[r] + s1[r]; }
        lrun += ps;
        bf16x8 pk[2][2];
#pragma unroll
        for (int j = 0; j < 2; ++j) {
            v4u w0, w1;
            w0.x = pk2(s0[8 * j + 0], s0[8 * j + 1]); w0.y = pk2(s0[8 * j + 2], s0[8 * j + 3]); w0.z = pk2(s0[8 * j + 4], s0[8 * j + 5]); w0.w = pk2(s0[8 * j + 6], s0[8 * j + 7]);
            w1.x = pk2(s1[8 * j + 0], s1[8 * j + 1]); w1.y = pk2(s1[8 * j + 2], s1[8 * j + 3]); w1.z = pk2(s1[8 * j + 4], s1[8 * j + 5]); w1.w = pk2(s1[8 * j + 6], s1[8 * j + 7]);
            pk[0][j] = __builtin_bit_cast(bf16x8, w0); pk[1][j] = __builtin_bit_cast(bf16x8, w1);
        }
#pragma unroll
        for (int kb = 0; kb < 2; ++kb)
#pragma unroll
            for (int j = 0; j < 2; ++j) {
                const int kofs = (2 * kb + j) * 32 + hi * 16;
                const v4u A0 = *(const LAS v4u*)(buf + KBYTES + q * VT_PITCH + kofs), A1 = *(const LAS v4u*)(buf + KBYTES + (32 + q) * VT_PITCH + kofs);
                o0 = __builtin_amdgcn_mfma_f32_32x32x16_bf16(__builtin_bit_cast(bf16x8, A0), pk[kb][j], o0, 0, 0, 0);
                o1 = __builtin_amdgcn_mfma_f32_32x32x16_bf16(__builtin_bit_cast(bf16x8, A1), pk[kb][j], o1, 0, 0, 0);
            }
        if (pre) { *(LAS v4u*)(nbuf + kl0) = rk0; if (has_k1) { const v4u t1_ = *(const v4u*)(kg1 + (size_t)(t + 1) * 64 * k_ld); *(LAS v4u*)(nbuf + kl1) = t1_; } *(LAS v2u*)(nbuf + vl) = (v2u){rv.x, rv.y}; *(LAS v2u*)(nbuf + vl + 16) = (v2u){rv.z, rv.w}; }
        __syncthreads();
    }
    __builtin_amdgcn_s_setprio(0);
    lrun += __shfl_xor(lrun, 32);
    const float inv = 1.0f / lrun;
    bf16* op = O + (size_t)(32 * wid + q) * o_ld + 4 * hi;
#pragma unroll
    for (int gq = 0; gq < 4; ++gq) {
        v2u w0, w1;
        w0.x = pk2(o0[4 * gq + 0] * inv, o0[4 * gq + 1] * inv); w0.y = pk2(o0[4 * gq + 2] * inv, o0[4 * gq + 3] * inv);
        w1.x = pk2(o1[4 * gq + 0] * inv, o1[4 * gq + 1] * inv); w1.y = pk2(o1[4 * gq + 2] * inv, o1[4 * gq + 3] * inv);
        *(v2u*)(op + 8 * gq) = w0; *(v2u*)(op + 32 + 8 * gq) = w1;
    }
#endif
}


#define ATT2_SOFTMAX(S0, S1, O0, O1, MR, LR, P00, P01, P10, P11) do { \
        float mx_ = S0[0]; \
        _Pragma("unroll") for (int r_ = 0; r_ < 16; ++r_) { mx_ = fmaxf(mx_, S0[r_]); mx_ = fmaxf(mx_, S1[r_]); } \
        mx_ = fmaxf(mx_, __shfl_xor(mx_, 32)); \
        if (__any(mx_ > MR + 8.0f)) {     \
            const float mn_ = fmaxf(MR, mx_), al_ = __builtin_amdgcn_exp2f(MR - mn_); \
            MR = mn_; LR *= al_; \
            _Pragma("unroll") for (int r_ = 0; r_ < 16; ++r_) { O0[r_] *= al_; O1[r_] *= al_; } } \
        float ps_ = 0.f; \
        _Pragma("unroll") for (int r_ = 0; r_ < 16; ++r_) { S0[r_] = __builtin_amdgcn_exp2f(S0[r_] - MR); S1[r_] = __builtin_amdgcn_exp2f(S1[r_] - MR); ps_ += S0[r_] + S1[r_]; } \
        LR += ps_; \
        { v4u w_; w_.x = pk2(S0[0], S0[1]); w_.y = pk2(S0[2], S0[3]); w_.z = pk2(S0[4], S0[5]); w_.w = pk2(S0[6], S0[7]); P00 = __builtin_bit_cast(bf16x8, w_); \
          w_.x = pk2(S0[8], S0[9]); w_.y = pk2(S0[10], S0[11]); w_.z = pk2(S0[12], S0[13]); w_.w = pk2(S0[14], S0[15]); P01 = __builtin_bit_cast(bf16x8, w_); \
          w_.x = pk2(S1[0], S1[1]); w_.y = pk2(S1[2], S1[3]); w_.z = pk2(S1[4], S1[5]); w_.w = pk2(S1[6], S1[7]); P10 = __builtin_bit_cast(bf16x8, w_); \
          w_.x = pk2(S1[8], S1[9]); w_.y = pk2(S1[10], S1[11]); w_.z = pk2(S1[12], S1[13]); w_.w = pk2(S1[14], S1[15]); P11 = __builtin_bit_cast(bf16x8, w_); } } while (0)
#define ATT2_SOFTMAX_FIX(S0, S1, LR, P00, P01, P10, P11) do {     \
        float ps_ = 0.f; \
        _Pragma("unroll") for (int r_ = 0; r_ < 16; ++r_) { S0[r_] = __builtin_amdgcn_exp2f(S0[r_]); S1[r_] = __builtin_amdgcn_exp2f(S1[r_]); ps_ += S0[r_] + S1[r_]; } \
        LR += ps_; \
        { v4u w_; w_.x = pk2(S0[0], S0[1]); w_.y = pk2(S0[2], S0[3]); w_.z = pk2(S0[4], S0[5]); w_.w = pk2(S0[6], S0[7]); P00 = __builtin_bit_cast(bf16x8, w_); \
          w_.x = pk2(S0[8], S0[9]); w_.y = pk2(S0[10], S0[11]); w_.z = pk2(S0[12], S0[13]); w_.w = pk2(S0[14], S0[15]); P01 = __builtin_bit_cast(bf16x8, w_); \
          w_.x = pk2(S1[0], S1[1]); w_.y = pk2(S1[2], S1[3]); w_.z = pk2(S1[4], S1[5]); w_.w = pk2(S1[6], S1[7]); P10 = __builtin_bit_cast(bf16x8, w_); \
          w_.x = pk2(S1[8], S1[9]); w_.y = pk2(S1[10], S1[11]); w_.z = pk2(S1[12], S1[13]); w_.w = pk2(S1[14], S1[15]); P11 = __builtin_bit_cast(bf16x8, w_); } } while (0)
__device__ __forceinline__ void attn_unit2(LAS unsigned char* lds, const bf16* __restrict__ Q, int q_ld, const bf16* __restrict__ K, int k_ld,
                                           const bf16* __restrict__ VT, int vt_ld, int nkeys, bf16* __restrict__ O, int o_ld) {
    constexpr int DK = 96, NCH = DK / 8, NDS = DK / 16, KCH = 1040  , KBYTES = NCH * KCH, VBYTES = 64 * VT_PITCH, BUFB = KBYTES + VBYTES;
    int tid_l = threadIdx.x; asm volatile("" : "+v"(tid_l));
    const int tid = tid_l, lane = tid & 63, wid = tid >> 6, q = lane & 31, hi = lane >> 5;
    const int NT = nkeys / 64;
    bf16x8 qfA[NDS], qfB[NDS];
    { const bf16* qp = Q + (size_t)(64 * wid + q) * q_ld + 8 * hi;
#pragma unroll
      for (int ds = 0; ds < NDS; ++ds) { qfA[ds] = *(const bf16x8*)(qp + 16 * ds); qfB[ds] = *(const bf16x8*)(qp + (size_t)32 * q_ld + 16 * ds); } }
    constexpr int KP = NCH * 64;
    const int k0key = tid / NCH, k0c = tid % NCH;
    const int k1idx = tid + NTHR, k1key = k1idx / NCH, k1c = k1idx % NCH;
    const bool has_k1 = (k1idx < KP);
    const int vd = tid >> 3, vpc = tid & 7;
    const unsigned kof0 = (unsigned)(k0key * k_ld + k0c * 8) * 2u, kof1 = (unsigned)((has_k1 ? k1key : 0) * k_ld + (has_k1 ? k1c : 0) * 8) * 2u, vof = (unsigned)(vd * vt_ld + vpc * 8) * 2u;
    const int kl0 = k0c * KCH + k0key * 16, kl1 = k1c * KCH + k1key * 16, vl = KBYTES + vd * VT_PITCH + (vpc >> 1) * 32 + (vpc & 1) * 8;
    v4u rk0, rk1, rv;
    rk0 = *(const v4u*)((const char*)K + kof0); if (has_k1) rk1 = *(const v4u*)((const char*)K + kof1); rv = *(const v4u*)((const char*)VT + vof);
    __syncthreads();
    *(LAS v4u*)(lds + kl0) = rk0; if (has_k1) *(LAS v4u*)(lds + kl1) = rk1; *(LAS v2u*)(lds + vl) = (v2u){rv.x, rv.y}; *(LAS v2u*)(lds + vl + 16) = (v2u){rv.z, rv.w};
    __syncthreads();
    f32x16 oA0 = {}, oA1 = {}, oB0 = {}, oB1 = {};
    float lA = 0.f, lB = 0.f;
    if (__builtin_amdgcn_readfirstlane(tid) >= 256) __builtin_amdgcn_s_setprio(1);
#pragma unroll 1
    for (int t = 0; t < NT; ++t) {
        LAS unsigned char* buf = lds + (t & 1) * BUFB;
        LAS unsigned char* nbuf = lds + ((t + 1) & 1) * BUFB;
        const bool pre = (t + 1 < NT);
        if (pre) { const char* kt_ = (const char*)K + (size_t)(t + 1) * 64 * k_ld * 2; const char* vt_ = (const char*)VT + (size_t)(t + 1) * 128; rk0 = *(const v4u*)(kt_ + kof0); if (has_k1) rk1 = *(const v4u*)(kt_ + kof1); rv = *(const v4u*)(vt_ + vof); }
        f32x16 sA0 = {}, sA1 = {}, sB0 = {}, sB1 = {};
#pragma unroll
        for (int ds = 0; ds < NDS; ++ds) {
            const bf16x8 a0 = *(const LAS bf16x8*)(buf + hi * KCH + q * 16 + ds * (2 * KCH));
            const bf16x8 a1 = *(const LAS bf16x8*)(buf + hi * KCH + q * 16 + ds * (2 * KCH) + 512);
            sA0 = __builtin_amdgcn_mfma_f32_32x32x16_bf16(a0, qfA[ds], sA0, 0, 0, 0);
            sA1 = __builtin_amdgcn_mfma_f32_32x32x16_bf16(a1, qfA[ds], sA1, 0, 0, 0);
            sB0 = __builtin_amdgcn_mfma_f32_32x32x16_bf16(a0, qfB[ds], sB0, 0, 0, 0);
            sB1 = __builtin_amdgcn_mfma_f32_32x32x16_bf16(a1, qfB[ds], sB1, 0, 0, 0);
        }
        bf16x8 pA00, pA01, pA10, pA11, pB00, pB01, pB10, pB11;
        ATT2_SOFTMAX_FIX(sA0, sA1, lA, pA00, pA01, pA10, pA11); ATT2_SOFTMAX_FIX(sB0, sB1, lB, pB00, pB01, pB10, pB11);
#pragma unroll
        for (int kb = 0; kb < 2; ++kb)
#pragma unroll
            for (int j = 0; j < 2; ++j) {
                const int kofs = (2 * kb + j) * 32 + hi * 16;
                const v4u A0 = *(const LAS v4u*)(buf + KBYTES + q * VT_PITCH + kofs), A1 = *(const LAS v4u*)(buf + KBYTES + (32 + q) * VT_PITCH + kofs);
                const bf16x8 pa = kb == 0 ? (j == 0 ? pA00 : pA01) : (j == 0 ? pA10 : pA11), pb = kb == 0 ? (j == 0 ? pB00 : pB01) : (j == 0 ? pB10 : pB11);
                oA0 = __builtin_amdgcn_mfma_f32_32x32x16_bf16(__builtin_bit_cast(bf16x8, A0), pa, oA0, 0, 0, 0);
                oA1 = __builtin_amdgcn_mfma_f32_32x32x16_bf16(__builtin_bit_cast(bf16x8, A1), pa, oA1, 0, 0, 0);
                oB0 = __builtin_amdgcn_mfma_f32_32x32x16_bf16(__builtin_bit_cast(bf16x8, A0), pb, oB0, 0, 0, 0);
                oB1 = __builtin_amdgcn_mfma_f32_32x32x16_bf16(__builtin_bit_cast(bf16x8, A1), pb, oB1, 0, 0, 0);
            }
        if (pre) { *(LAS v4u*)(nbuf + kl0) = rk0; if (has_k1) *(LAS v4u*)(nbuf + kl1) = rk1; *(LAS v2u*)(nbuf + vl) = (v2u){rv.x, rv.y}; *(LAS v2u*)(nbuf + vl + 16) = (v2u){rv.z, rv.w}; }
        __syncthreads();
    }
    __builtin_amdgcn_s_setprio(0);
    lA += __shfl_xor(lA, 32); lB += __shfl_xor(lB, 32);
    const float invA = 1.0f / lA, invB = 1.0f / lB;
    bf16* opA = O + (size_t)(64 * wid + q) * o_ld + 4 * hi; bf16* opB = opA + (size_t)32 * o_ld;
#pragma unroll
    for (int gq = 0; gq < 4; ++gq) {
        v2u w0, w1;
        w0.x = pk2(oA0[4 * gq + 0] * invA, oA0[4 * gq + 1] * invA); w0.y = pk2(oA0[4 * gq + 2] * invA, oA0[4 * gq + 3] * invA);
        w1.x = pk2(oA1[4 * gq + 0] * invA, oA1[4 * gq + 1] * invA); w1.y = pk2(oA1[4 * gq + 2] * invA, oA1[4 * gq + 3] * invA);
        *(v2u*)(opA + 8 * gq) = w0; *(v2u*)(opA + 32 + 8 * gq) = w1;
        w0.x = pk2(oB0[4 * gq + 0] * invB, oB0[4 * gq + 1] * invB); w0.y = pk2(oB0[4 * gq + 2] * invB, oB0[4 * gq + 3] * invB);
        w1.x = pk2(oB1[4 * gq + 0] * invB, oB1[4 * gq + 1] * invB); w1.y = pk2(oB1[4 * gq + 2] * invB, oB1[4 * gq + 3] * invB);
        *(v2u*)(opB + 8 * gq) = w0; *(v2u*)(opB + 32 + 8 * gq) = w1;
    }
}


__device__ __forceinline__ void attn_unit3(LAS unsigned char* lds, const bf16* __restrict__ Q, int q_ld, const bf16* __restrict__ K, int k_ld,
                                           const bf16* __restrict__ VT, int vt_ld, int nkeys, bf16* __restrict__ O, int o_ld) {
    constexpr int DK = 96, NCH = DK / 8, NDS = DK / 16, KCH = 1040, KBYTES = NCH * KCH, VBYTES = 64 * VT_PITCH, VOFF = 2 * KBYTES;
    int tid_l = threadIdx.x; asm volatile("" : "+v"(tid_l));
    const int tid = tid_l, lane = tid & 63, wid = tid >> 6, q = lane & 31, hi = lane >> 5;
    const int NT = nkeys / 64;
    const bool grpA = (wid < 4);
    bf16x8 qfA[NDS], qfB[NDS];
    { const bf16* qp = Q + (size_t)(64 * wid + q) * q_ld + 8 * hi;
#pragma unroll
      for (int ds = 0; ds < NDS; ++ds) { qfA[ds] = *(const bf16x8*)(qp + 16 * ds); qfB[ds] = *(const bf16x8*)(qp + (size_t)32 * q_ld + 16 * ds); } }
    constexpr int KP = NCH * 64;
    const int k0key = tid / NCH, k0c = tid % NCH;
    const int k1idx = tid + NTHR, k1key = k1idx / NCH, k1c = k1idx % NCH;
    const bool has_k1 = (k1idx < KP);
    const int vd = tid >> 3, vpc = tid & 7;
    const unsigned kof0 = (unsigned)(k0key * k_ld + k0c * 8) * 2u, kof1 = (unsigned)((has_k1 ? k1key : 0) * k_ld + (has_k1 ? k1c : 0) * 8) * 2u, vof = (unsigned)(vd * vt_ld + vpc * 8) * 2u;
    const int kl0 = k0c * KCH + k0key * 16, kl1 = k1c * KCH + k1key * 16, vl = VOFF + vd * VT_PITCH + (vpc >> 1) * 32 + (vpc & 1) * 8;
    v4u rk0, rk1, rv;
#define A3_LOADK(t_) do { const char* kt_ = (const char*)K + (size_t)(t_) * 64 * k_ld * 2; rk0 = *(const v4u*)(kt_ + kof0); if (has_k1) rk1 = *(const v4u*)(kt_ + kof1); } while (0)
#define A3_LOADV(t_) do { rv = *(const v4u*)((const char*)VT + (size_t)(t_) * 128 + vof); } while (0)
#define A3_STOREK(s_) do { *(LAS v4u*)(lds + (s_) * KBYTES + kl0) = rk0; if (has_k1) *(LAS v4u*)(lds + (s_) * KBYTES + kl1) = rk1; } while (0)
#define A3_STOREV(s_) do { *(LAS v2u*)(lds + (s_) * VBYTES + vl) = (v2u){rv.x, rv.y}; *(LAS v2u*)(lds + (s_) * VBYTES + vl + 16) = (v2u){rv.z, rv.w}; } while (0)
#define A3_BAR() asm volatile("s_waitcnt lgkmcnt(0)\n\ts_barrier" ::: "memory")
    f32x16 oA0 = {}, oA1 = {}, oB0 = {}, oB1 = {}, sA0 = {}, sA1 = {}, sB0 = {}, sB1 = {};
#define A3_PKGET(S_, i_) __builtin_bit_cast(bf16x8, (f32x4){S_[4 * (i_)], S_[4 * (i_) + 1], S_[4 * (i_) + 2], S_[4 * (i_) + 3]})
#define A3_PKSET(S_, i_, P_) do { const f32x4 w4_ = __builtin_bit_cast(f32x4, P_); S_[4 * (i_)] = w4_[0]; S_[4 * (i_) + 1] = w4_[1]; S_[4 * (i_) + 2] = w4_[2]; S_[4 * (i_) + 3] = w4_[3]; } while (0)
    float lA = 0.f, lB = 0.f;
#define A3_X(tx_) do { const int tx = (tx_); \
        if (tx >= 1) { LAS unsigned char* vb_ = lds + ((tx - 1) & 1) * VBYTES + VOFF; \
            _Pragma("unroll") for (int kj = 0; kj < 4; ++kj) { \
                const int kofs = kj * 32 + hi * 16; \
                const v4u A0 = *(const LAS v4u*)(vb_ + q * VT_PITCH + kofs), A1 = *(const LAS v4u*)(vb_ + (32 + q) * VT_PITCH + kofs); \
                const bf16x8 pa = A3_PKGET(sA0, kj), pb = A3_PKGET(sB0, kj); \
                oA0 = __builtin_amdgcn_mfma_f32_32x32x16_bf16(__builtin_bit_cast(bf16x8, A0), pa, oA0, 0, 0, 0); \
                oA1 = __builtin_amdgcn_mfma_f32_32x32x16_bf16(__builtin_bit_cast(bf16x8, A1), pa, oA1, 0, 0, 0); \
                oB0 = __builtin_amdgcn_mfma_f32_32x32x16_bf16(__builtin_bit_cast(bf16x8, A0), pb, oB0, 0, 0, 0); \
                oB1 = __builtin_amdgcn_mfma_f32_32x32x16_bf16(__builtin_bit_cast(bf16x8, A1), pb, oB1, 0, 0, 0); } } \
        if (tx < NT) { LAS unsigned char* kb_ = lds + (tx & 1) * KBYTES; \
            _Pragma("unroll") for (int r_ = 0; r_ < 16; ++r_) { sA0[r_] = 0.f; sA1[r_] = 0.f; sB0[r_] = 0.f; sB1[r_] = 0.f; } \
            _Pragma("unroll") for (int ds = 0; ds < NDS; ++ds) { \
                const bf16x8 a0 = *(const LAS bf16x8*)(kb_ + hi * KCH + q * 16 + ds * (2 * KCH)); \
                const bf16x8 a1 = *(const LAS bf16x8*)(kb_ + hi * KCH + q * 16 + ds * (2 * KCH) + 512); \
                sA0 = __builtin_amdgcn_mfma_f32_32x32x16_bf16(a0, qfA[ds], sA0, 0, 0, 0); \
                sA1 = __builtin_amdgcn_mfma_f32_32x32x16_bf16(a1, qfA[ds], sA1, 0, 0, 0); \
                sB0 = __builtin_amdgcn_mfma_f32_32x32x16_bf16(a0, qfB[ds], sB0, 0, 0, 0); \
                sB1 = __builtin_amdgcn_mfma_f32_32x32x16_bf16(a1, qfB[ds], sB1, 0, 0, 0); } } } while (0)
#define A3_Y() do { bf16x8 p0_, p1_, p2_, p3_; \
        ATT2_SOFTMAX_FIX(sA0, sA1, lA, p0_, p1_, p2_, p3_); A3_PKSET(sA0, 0, p0_); A3_PKSET(sA0, 1, p1_); A3_PKSET(sA0, 2, p2_); A3_PKSET(sA0, 3, p3_); \
        ATT2_SOFTMAX_FIX(sB0, sB1, lB, p0_, p1_, p2_, p3_); A3_PKSET(sB0, 0, p0_); A3_PKSET(sB0, 1, p1_); A3_PKSET(sB0, 2, p2_); A3_PKSET(sB0, 3, p3_); } while (0)
    A3_LOADK(0);
    __syncthreads();
    A3_STOREK(0);
    A3_LOADK(1);
    A3_BAR();
#pragma unroll 1
    for (int t = 0; t <= NT; ++t) {
        if (t < NT) A3_LOADV(t);
        if (grpA) A3_X(t); else if (t >= 1) A3_Y();
        if (t + 1 < NT) A3_STOREK((t + 1) & 1);
        A3_BAR();
        if (t + 2 < NT) A3_LOADK(t + 2);
        if (grpA) { if (t < NT) A3_Y(); } else A3_X(t);
        if (t < NT) A3_STOREV(t & 1);
        A3_BAR();
    }
#undef A3_LOADK
#undef A3_LOADV
#undef A3_STOREK
#undef A3_STOREV
#undef A3_BAR
#undef A3_X
#undef A3_PKGET
#undef A3_PKSET
#undef A3_Y
    lA += __shfl_xor(lA, 32); lB += __shfl_xor(lB, 32);
    const float invA = 1.0f / lA, invB = 1.0f / lB;
    int tid_e = threadIdx.x; asm volatile("" : "+v"(tid_e));
    const int wid_e = tid_e >> 6, q_e = tid_e & 31, hi_e = (tid_e >> 5) & 1;
    bf16* opA = O + (size_t)(64 * wid_e + q_e) * o_ld + 4 * hi_e; bf16* opB = opA + (size_t)32 * o_ld;
#pragma unroll
    for (int gq = 0; gq < 4; ++gq) {
        v2u w0, w1;
        w0.x = pk2(oA0[4 * gq + 0] * invA, oA0[4 * gq + 1] * invA); w0.y = pk2(oA0[4 * gq + 2] * invA, oA0[4 * gq + 3] * invA);
        w1.x = pk2(oA1[4 * gq + 0] * invA, oA1[4 * gq + 1] * invA); w1.y = pk2(oA1[4 * gq + 2] * invA, oA1[4 * gq + 3] * invA);
        *(v2u*)(opA + 8 * gq) = w0; *(v2u*)(opA + 32 + 8 * gq) = w1;
        w0.x = pk2(oB0[4 * gq + 0] * invB, oB0[4 * gq + 1] * invB); w0.y = pk2(oB0[4 * gq + 2] * invB, oB0[4 * gq + 3] * invB);
        w1.x = pk2(oB1[4 * gq + 0] * invB, oB1[4 * gq + 1] * invB); w1.y = pk2(oB1[4 * gq + 2] * invB, oB1[4 * gq + 3] * invB);
        *(v2u*)(opB + 8 * gq) = w0; *(v2u*)(opB + 32 + 8 * gq) = w1;
    }
    __syncthreads();
}

#define DECL_PTRS \
    int tid_p = threadIdx.x; asm volatile("" : "+v"(tid_p));     \
    const int tid = tid_p, lane = tid & 63, wave = __builtin_amdgcn_readfirstlane(tid >> 6); \
    const int gw = vcu * NWAVES + wave, gt = bx * NTHR + tid; (void)gw; (void)gt; (void)lane; \
    size_t zoff_ = 0; asm volatile("" : "+s"(zoff_));     \
    unsigned char* ws = a.ws + zoff_; unsigned char* dob = (unsigned char*)a.out + zoff_; \
    const float* xp = a.in[0]; const float* xs = a.in[1]; const float* memp = a.in[2]; const float* mems = a.in[3]; \
    bf16* WinT = (bf16*)(ws + WS_WIN); bf16* WuqT = (bf16*)(ws + WS_WUQ); bf16* WukvT = (bf16*)(ws + WS_WUKV); bf16* WgluT = (bf16*)(ws + WS_WGLU); \
    bf16* WmkvT = (bf16*)(ws + WS_WMKV); bf16* WbT = (bf16*)(ws + WS_WB); \
    bf16* WoutT = (bf16*)(ws + WS_WOUT); bf16* WguT = (bf16*)(ws + WS_WGU); bf16* WdT = (bf16*)(ws + WS_WD); \
    bf16* BtY = (bf16*)(ws + WS_BTY); bf16* Bst = (bf16*)(ws + WS_BST); float* Klag = (float*)(ws + WS_KLAG); \
    float* RQ = (float*)(ws + WS_RQ); float* RKV = (float*)(ws + WS_RKV); bf16* MK = (bf16*)(ws + WS_MK); bf16* MVT = (bf16*)(ws + WS_MVT); \
    bf16* MQ = (bf16*)(ws + WS_MQ); bf16* Ure = (bf16*)(ws + WS_URE); float* Sst = (float*)(ws + WS_SST); bf16* Merged = (bf16*)(ws + WS_MERGED); \
    bf16* Zs = (bf16*)(ws + WS_ZS); bf16* OB = (bf16*)(ws + WS_OB); bf16* Yact = (bf16*)(ws + WS_YACT); \
    bf16* H2 = (bf16*)(ws + WS_H2); bf16* Gt = (bf16*)(ws + WS_G); bf16* Act = (bf16*)(ws + WS_ACT); \
    bf16* XN = (bf16*)(dob + DO_XN); bf16* MEMN = (bf16*)(dob + DO_MEMN); bf16* Qf = (bf16*)(dob + DO_QF); bf16* Kf = (bf16*)(dob + DO_KF); bf16* VTb = (bf16*)(dob + DO_VT); \
    const float* lam_re = a.in[13]; const float* lam_im = a.in[14]; const float* logstep = a.in[15]; \
    const float* b_re = a.in[16]; const float* b_im = a.in[17]; const float* c_re = a.in[18]; const float* c_im = a.in[19];

struct Args { const float* in[33]; float* out; unsigned char* ws; };

__global__ void __launch_bounds__(NTHR, 2) fwd_megakernel(Args a) {
    extern __shared__ __attribute__((aligned(16))) unsigned char lds_raw[];
    LAS unsigned char* lds = (LAS unsigned char*)lds_raw;
    cg::grid_group grid = cg::this_grid();
    const int G = gridDim.x, bx = blockIdx.x;
    const int vcu = (G % 8 == 0) ? (bx % 8) * (G / 8) + bx / 8 : bx;
    const int NGW = G * NWAVES, NGT = G * NTHR;
    volatile LAS unsigned* bst = (volatile LAS unsigned*)(lds + 131072 + 64);
    if (threadIdx.x < 2) bst[threadIdx.x] = 0u;
    __syncthreads();
    XcdBarrier xbar = xcd_barrier_post((unsigned*)(a.ws + WS_BAR), bst);
#if (PHM >> 0) & 1
    for (int rep_ = 0; rep_ < 1 + ((DUPM >> 0) & 1); ++rep_) { DECL_PTRS;
    {
        LAS float* scr = (LAS float*)(lds + wave * 16384);
#define TRANS(W, K_, N_, WT, LDW, RM, KS) for (int it = gw; it < ((K_) / 64) * ((N_) / 32); it += NGW) transpose_item((W), (K_), (N_), (WT), (LDW), RM, (KS), scr, it, lane)
        TRANS(a.in[6], 1024, 4256, WinT, 1024, RmWin(), (const float*)nullptr);
        TRANS(a.in[9], 384, 768, WuqT, 384, RmId(), a.in[7]);
        TRANS(a.in[10], 256, 1024, WukvT, 256, RmUkv(), a.in[8]);
        TRANS(a.in[21], 256, 256, WgluT, 256, RmId(), (const float*)nullptr);
        TRANS(a.in[22], 1024, 512, WmkvT, 1024, RmId(), (const float*)nullptr);
        TRANS(a.in[25], 512, 1024, WbT, 1024, RmId(), (const float*)nullptr);
        TRANS(a.in[26], 256, 1024, WbT + 512, 1024, RmId(), (const float*)nullptr);
        TRANS(a.in[27], 256, 1024, WbT + 768, 1024, RmId(), (const float*)nullptr);
        TRANS(a.in[28], 1024, 1024, WoutT, 1024, RmId(), (const float*)nullptr);
        TRANS(a.in[30], 1024, 2816, WguT, 1024, RmGate(), a.in[29]);
        TRANS(a.in[31], 1024, 2816, WguT, 1024, RmUp(), a.in[29]);
        TRANS(a.in[32], 2816, 1024, WdT, 2816, RmId(), (const float*)nullptr);
#undef TRANS
        for (int i = gt; i < MT; i += NGT) ((float*)(ws + WS_RSS))[i] = 0.f;
        for (int i = gt; i < 96 * 1024 / 8; i += NGT) *(v4u*)(WinT + (size_t)672 * 1024 + (size_t)i * 8) = (v4u){0u, 0u, 0u, 0u};
        for (int m = gw; m < MT; m += 4 * NGW) {
            if (m + 3 * NGW < MT) {
                const f32x4* xr[4]; f32x4 v[4][4]; float s[4];
#pragma unroll
                for (int u = 0; u < 4; ++u) { xr[u] = (const f32x4*)xrow_ptr(xp, xs, m + u * NGW) + lane;
#pragma unroll
                    for (int j = 0; j < 4; ++j) v[u][j] = xr[u][64 * j]; }
#pragma unroll
                for (int u = 0; u < 4; ++u) { s[u] = 0.f;
#pragma unroll
                    for (int j = 0; j < 4; ++j) s[u] += (v[u][j].x * v[u][j].x + v[u][j].y * v[u][j].y) + (v[u][j].z * v[u][j].z + v[u][j].w * v[u][j].w); }
#pragma unroll
                for (int u = 0; u < 4; ++u) { const float r = 1.0f / sqrtf(wave_sum(s[u]) * (1.f / DM) + EPS);
                    unsigned long long* o8 = (unsigned long long*)(XN + (size_t)(m + u * NGW) * DM) + lane; const f32x4* gr = (const f32x4*)a.in[4] + lane;
#pragma unroll
                    for (int j = 0; j < 4; ++j) { const f32x4 gg = gr[64 * j];
                        o8[64 * j] = (unsigned long long)pk2(v[u][j].x * r * gg.x, v[u][j].y * r * gg.y) | ((unsigned long long)pk2(v[u][j].z * r * gg.z, v[u][j].w * r * gg.w) << 32); } }
            } else { for (int u = 0; u < 4; ++u) if (m + u * NGW < MT) rms_row_to_bf16(xrow_ptr(xp, xs, m + u * NGW), a.in[4], XN + (size_t)(m + u * NGW) * DM, lane); }
        }
        for (int m = gw; m < MMEM; m += NGW) rms_row_to_bf16(m < NPROMPT * MEMTOK ? memp + (size_t)m * DM : mems + (size_t)(m - NPROMPT * MEMTOK) * DM, a.in[5], MEMN + (size_t)m * DM, lane);
        {
            LAS float* wre = (LAS float*)lds; LAS float* wim = wre + 64;
            for (int item = bx; item < 16 * 2 * 64; item += G) {
                const int k = item & 63, dir = (item >> 6) & 1, g = item >> 7, gd = dir * 16 + g;
                __syncthreads();
                if (tid < 64) { const int p = tid; const float dt = expf(logstep[gd]); const float lre = lam_re[gd * 64 + p], lim = lam_im[gd * 64 + p];
                    float zr, zi, pr, pi; zcoef(lre, lim, dt, zr, zi); cpowk(lre, lim, dt, k, pr, pi);
                    wre[p] = pr * zr - pi * zi; wim[p] = pr * zi + pi * zr; }
                __syncthreads();
                if (tid < 256) { const int hp = tid & 15, h = tid >> 4; float acc = 0.f;
                    for (int p = 0; p < 64; ++p) {
                        const float br = b_re[(gd * 64 + p) * 16 + hp], bi = b_im[(gd * 64 + p) * 16 + hp];
                        const float wr = wre[p] * br - wim[p] * bi, wi = wre[p] * bi + wim[p] * br;
                        acc += c_re[(gd * 16 + h) * 64 + p] * wr - c_im[(gd * 16 + h) * 64 + p] * wi; }
                    Klag[(size_t)item * 256 + tid] = acc; }
            }
            __syncthreads();
        }
        for (int idx = gt; idx < 16 * 2 * 64 * 64; idx += NGT) {
            const int p = idx & 63, s = (idx >> 6) & 63, dir = (idx >> 12) & 1, g = idx >> 13, gd = dir * 16 + g;
            const float dt = expf(logstep[gd]); const float lre = lam_re[gd * 64 + p], lim = lam_im[gd * 64 + p];
            float zr, zi, pr, pi; zcoef(lre, lim, dt, zr, zi); cpowk(lre, lim, dt, dir == 0 ? 63 - s : s, pr, pi);
            const float wr0 = pr * zr - pi * zi, wi0 = pr * zi + pi * zr;
            const float* brp = b_re + (gd * 64 + p) * 16; const float* bip = b_im + (gd * 64 + p) * 16;
            float vr[16], vi[16];
#pragma unroll
            for (int hp = 0; hp < 16; ++hp) { const float br = brp[hp], bi = bip[hp]; vr[hp] = wr0 * br - wi0 * bi; vi[hp] = wr0 * bi + wi0 * br; }
            bf16* dre = Bst + ((size_t)(g * 256 + dir * 128 + p)) * 1024 + s * 16; bf16* dim_ = dre + (size_t)64 * 1024;
            v4u o;
            o.x = pk2(vr[0], vr[1]); o.y = pk2(vr[2], vr[3]); o.z = pk2(vr[4], vr[5]); o.w = pk2(vr[6], vr[7]); *(v4u*)dre = o;
            o.x = pk2(vr[8], vr[9]); o.y = pk2(vr[10], vr[11]); o.z = pk2(vr[12], vr[13]); o.w = pk2(vr[14], vr[15]); *(v4u*)(dre + 8) = o;
            o.x = pk2(vi[0], vi[1]); o.y = pk2(vi[2], vi[3]); o.z = pk2(vi[4], vi[5]); o.w = pk2(vi[6], vi[7]); *(v4u*)dim_ = o;
            o.x = pk2(vi[8], vi[9]); o.y = pk2(vi[10], vi[11]); o.z = pk2(vi[12], vi[13]); o.w = pk2(vi[14], vi[15]); *(v4u*)(dim_ + 8) = o;
        }
        for (int idx = gt; idx < 16 * 2 * 64 * 64; idx += NGT) {
            const int p = idx & 63, t = (idx >> 6) & 63, dir = (idx >> 12) & 1, g = idx >> 13, gd = dir * 16 + g;
            const float dt = expf(logstep[gd]); const float lre = lam_re[gd * 64 + p], lim = lam_im[gd * 64 + p];
            float pr, pi; cpowk(lre, lim, dt, dir == 0 ? t + 1 : 64 - t, pr, pi);
            bf16* d0 = BtY + ((size_t)g * 1024 + t * 16) * ULD + 1024 + dir * 128 + p;
#pragma unroll
            for (int h = 0; h < 16; ++h) { const float cr = c_re[(gd * 16 + h) * 64 + p], ci = c_im[(gd * 16 + h) * 64 + p];
                const float wr = cr * pr - ci * pi, wi = cr * pi + ci * pr;
                d0[(size_t)h * ULD] = (bf16)f2bf(wr); d0[(size_t)h * ULD + 64] = (bf16)f2bf(-wi); }
        }
    }
    }
#endif
    if (a.ws == nullptr) grid.sync();
    xcd_barrier(xbar);

#if EXTRA_SYNCS
    for (int es_ = 0; es_ < EXTRA_SYNCS; ++es_) grid.sync();
#endif
#if (PHM >> 1) & 1
    for (int rep_ = 0; rep_ < 1 + ((DUPM >> 1) & 1); ++rep_) { DECL_PTRS;
    {
        { pg8::Gemm g{XN, WinT, MT, NZ, 1024, 1024, 1024}; pg8::StaticOrder S; S.init(MT, NZ, G, bx); EpiZ E{Zs, Gt}; run_gemm(lds, g, S, E); }
        { pg8::Gemm g{MEMN, WmkvT, MMEM, 256, 1024, 1024, 1024}; pg8::StaticOrder S; S.init(MMEM, 256, G, (bx + G - 64) % G);       EpiStore E{MK, 256}; run_gemm(lds, g, S, E); }
        { pg8::Gemm g{WmkvT + (size_t)256 * 1024, MEMN, 256, MMEM, 1024, 1024, 1024}; pg8::StaticOrder S; S.init(256, MMEM, G, (bx + G - 128) % G); EpiStore E{MVT, MMEM}; run_gemm(lds, g, S, E); }
        for (int idx = gt; idx < 16 * 1024 * 128; idx += NGT) {
            const int k8 = idx & 127, n = (idx >> 7) & 1023, g = idx >> 17;
            const int t = n >> 4, h = n & 15, s = k8 >> 1, hp0 = (k8 & 1) * 8;
            float v[8];
#pragma unroll
            for (int i = 0; i < 8; ++i) v[i] = 0.f;
            if (t >= s) { const float* kp = Klag + ((size_t)((g * 2 + 0) * 64 + (t - s)) * 256 + h * 16 + hp0);
#pragma unroll
                for (int i = 0; i < 8; ++i) v[i] += kp[i]; }
            if (s >= t) { const float* kp = Klag + ((size_t)((g * 2 + 1) * 64 + (s - t)) * 256 + h * 16 + hp0);
#pragma unroll
                for (int i = 0; i < 8; ++i) v[i] += kp[i]; }
            v4u o; o.x = pk2(v[0], v[1]); o.y = pk2(v[2], v[3]); o.z = pk2(v[4], v[5]); o.w = pk2(v[6], v[7]);
            *(v4u*)(BtY + ((size_t)g * 1024 + n) * ULD + k8 * 8) = o;
        }
    }
    }
#endif
    xcd_barrier(xbar);

#if (PHM >> 2) & 1
    for (int rep_ = 0; rep_ < 1 + ((DUPM >> 2) & 1); ++rep_) { DECL_PTRS;
    {
        const float* gmq = a.in[23]; const float* gmk = a.in[24];
        for (int m0 = gw; m0 < MT; m0 += 4 * NGW) {
            v4u q0[4], q1[4], q2[4];
#pragma unroll
            for (int u = 0; u < 4; ++u) { const int mu = m0 + u * NGW; q0[u] = q1[u] = q2[u] = (v4u){0u, 0u, 0u, 0u};
                if (mu < MT) { const v4u* zr = (const v4u*)(Zs + (size_t)mu * NZS); q0[u] = zr[lane]; q1[u] = zr[64 + lane]; if (lane < 32) q2[u] = zr[128 + lane]; } }
#pragma unroll
            for (int u = 0; u < 4; ++u) { const int m = m0 + u * NGW; if (m >= MT) break;
            const v4u p0 = q0[u], p1 = q1[u], p2 = q2[u];
            const float sq0 = sumsq8(p0), sq1 = sumsq8(p1), sq2 = sumsq8(p2);
            float sa = lane < 48 ? sq0 : 0.f, sb = (lane >= 48 ? sq0 : 0.f) + (lane < 16 ? sq1 : 0.f);
            sa = wave_sum(sa); sb = wave_sum(sb);
            { const float rq = 1.0f / sqrtf(sa * (1.f / 384.f) + EPS), rkv = 1.0f / sqrtf(sb * (1.f / 256.f) + EPS);
              const float r0 = lane < 48 ? rq : rkv; v4u o;
              o.x = pk2(bflo(p0.x) * r0, bfhi(p0.x) * r0); o.y = pk2(bflo(p0.y) * r0, bfhi(p0.y) * r0); o.z = pk2(bflo(p0.z) * r0, bfhi(p0.z) * r0); o.w = pk2(bflo(p0.w) * r0, bfhi(p0.w) * r0);
              ((v4u*)(Zs + (size_t)m * NZS))[lane] = o;
              if (lane < 16) { o.x = pk2(bflo(p1.x) * rkv, bfhi(p1.x) * rkv); o.y = pk2(bflo(p1.y) * rkv, bfhi(p1.y) * rkv); o.z = pk2(bflo(p1.z) * rkv, bfhi(p1.z) * rkv); o.w = pk2(bflo(p1.w) * rkv, bfhi(p1.w) * rkv);
                  ((v4u*)(Zs + (size_t)m * NZS))[64 + lane] = o; } }
            if (lane >= 32) { const int j = lane - 32; *(v4u*)(Ure + ((size_t)((j >> 1) * SROWS + (m >> 6)) * ULD + (m & 63) * 16 + (j & 1) * 8)) = p1; }
            float hq = sq2; hq += __shfl_xor(hq, 1); hq += __shfl_xor(hq, 2); hq += __shfl_xor(hq, 4);
            if (lane < 32) { const float r = MQSCALE / sqrtf(hq * (1.f / 64.f) + EPS); const float* gg = gmq + (lane & 7) * 8; v4u o;
                o.x = pk2(bflo(p2.x) * r * gg[0], bfhi(p2.x) * r * gg[1]); o.y = pk2(bflo(p2.y) * r * gg[2], bfhi(p2.y) * r * gg[3]);
                o.z = pk2(bflo(p2.z) * r * gg[4], bfhi(p2.z) * r * gg[5]); o.w = pk2(bflo(p2.w) * r * gg[6], bfhi(p2.w) * r * gg[7]);
                *(v4u*)(MQ + (size_t)m * 256 + lane * 8) = o; }
            }
        }
        for (int m = gw; m < MMEM; m += NGW) {
            v4u p2 = (v4u){0u, 0u, 0u, 0u}; if (lane < 32) p2 = *(const v4u*)(MK + (size_t)m * 256 + lane * 8);
            float hq = sumsq8(p2); hq += __shfl_xor(hq, 1); hq += __shfl_xor(hq, 2); hq += __shfl_xor(hq, 4);
            if (lane < 32) { const float r = 1.0f / sqrtf(hq * (1.f / 64.f) + EPS); const float* gg = gmk + (lane & 7) * 8; v4u o;
                o.x = pk2(bflo(p2.x) * r * gg[0], bfhi(p2.x) * r * gg[1]); o.y = pk2(bflo(p2.y) * r * gg[2], bfhi(p2.y) * r * gg[3]);
                o.z = pk2(bflo(p2.z) * r * gg[4], bfhi(p2.z) * r * gg[5]); o.w = pk2(bflo(p2.w) * r * gg[6], bfhi(p2.w) * r * gg[7]);
                *(v4u*)(MK + (size_t)m * 256 + lane * 8) = o; }
        }
    }
    }
#endif
    xcd_barrier(xbar);

#if (PHM >> 3) & 1
    for (int rep_ = 0; rep_ < 1 + ((DUPM >> 3) & 1); ++rep_) { DECL_PTRS;
    {
#if (PH3M >> 0) & 1
        { pg8::Gemm g{Zs, WuqT, MT, 768, 384, NZS, 384}; pg8::StaticOrder S; S.init(MT, 768, G, bx); EpiStore E{Qf, 768}; run_gemm4(lds, g, S, E); }
#endif
#if (PH3M >> 1) & 1
        { pg8::Gemm g{Zs + 384, WukvT, MT, 512, 256, NZS, 256}; pg8::StaticOrder S; S.init(MT, 512, G, (bx + G - 192) % G); EpiKnope E{Kf}; run_gemm4(lds, g, S, E); }
#endif
#if (PH3M >> 2) & 1
        { pg8::Gemm g{WukvT + (size_t)512 * 256, Zs + 384, 512, MT, 256, 256, NZS}; pg8::StaticOrder S; S.init(512, MT, G, (bx + G - 64) % G); EpiStore E{VTb, MT}; run_gemm4(lds, g, S, E); }
#endif
#if (PH3M >> 3) & 1
        { pg8::Gemm g{Ure, Bst, 16 * SROWS, 16 * 256, 1024, ULD, 1024}; BatchedOrder S{1, G, (bx + G - 192) % G}; EpiSst E{Sst}; run_gemm4(lds, g, S, E); }
#endif
    }
    }
#endif
    xcd_barrier(xbar);

#if (PHM >> 4) & 1
    for (int rep_ = 0; rep_ < 1 + ((DUPM >> 4) & 1); ++rep_) { DECL_PTRS;
    {
        {
            const int rt = (G - 1 - bx) * NTHR + tid;
            if (rt < 16 * NBATCH * 128) {
                const int p = rt & 63, dir = (rt >> 6) & 1, b = (rt >> 7) % NBATCH, g = (rt >> 7) / NBATCH, gd = dir * 16 + g;
                const float dt = expf(logstep[gd]); float ar, ai; cpowk(lam_re[gd * 64 + p], lam_im[gd * 64 + p], dt, 64, ar, ai);
                float xr = 0.f, xi = 0.f;
                const size_t rbase = (size_t)g * SROWS + (size_t)b * NCHUNK;
                for (int c8 = 0; c8 < NCHUNK; c8 += 8) {
                    float sr[8], si[8];
#pragma unroll
                    for (int i = 0; i < 8; ++i) { const int c = dir == 0 ? c8 + i : NCHUNK - 1 - (c8 + i); const float* sp = Sst + (rbase + c) * 256 + dir * 128 + p; sr[i] = sp[0]; si[i] = sp[64]; }
#pragma unroll
                    for (int i = 0; i < 8; ++i) { const int c = dir == 0 ? c8 + i : NCHUNK - 1 - (c8 + i); bf16* up = Ure + (rbase + c) * ULD + 1024 + dir * 128 + p;
                        up[0] = (bf16)f2bf(xr); up[64] = (bf16)f2bf(xi);
                        const float nr = ar * xr - ai * xi + sr[i], ni = ar * xi + ai * xr + si[i]; xr = nr; xi = ni; }
                }
            }
        }
        const float* gq = a.in[11]; const float* gk = a.in[12];
        for (int m0 = gw * 8; m0 < MT; m0 += NGW * 8) {
            const int row = m0 + (lane >> 3), h = lane & 7, pos = row & (SEQ - 1);
            v4u pc[12];
            { v4u* qp = (v4u*)(Qf + (size_t)row * 768 + h * 96);
#pragma unroll
              for (int i = 0; i < 12; ++i) pc[i] = qp[i];
              head96_norm_rope(pc, gq, pos, QSCALE);
#pragma unroll
              for (int i = 0; i < 12; ++i) qp[i] = pc[i]; }
            { v4u* kp = (v4u*)(Kf + (size_t)row * 768 + h * 96); const v4u* rp = (const v4u*)(Zs + (size_t)row * NZS + 640);
#pragma unroll
              for (int i = 0; i < 8; ++i) pc[i] = kp[i];
#pragma unroll
              for (int i = 0; i < 4; ++i) pc[8 + i] = rp[i];
              head96_norm_rope(pc, gk, pos, 1.0f);
#pragma unroll
              for (int i = 0; i < 12; ++i) kp[i] = pc[i]; }
        }
    }
    }
#endif
    xcd_barrier(xbar);

#if (PHM >> 5) & 1
    for (int rep_ = 0; rep_ < 1 + ((DUPM >> 5) & 1); ++rep_) { DECL_PTRS;
    {
#if (PH5M & 1)
        bool fixref;
        { float gq_ = lane < 48 ? fmaxf(fabsf(a.in[11][lane]), fabsf(a.in[11][lane + 48])) : 0.f, gk_ = lane < 48 ? fmaxf(fabsf(a.in[12][lane]), fabsf(a.in[12][lane + 48])) : 0.f;
#pragma unroll
          for (int o_ = 1; o_ < 64; o_ <<= 1) { gq_ = fmaxf(gq_, __shfl_xor(gq_, o_)); gk_ = fmaxf(gk_, __shfl_xor(gk_, o_)); }
          const float bound_ = 9.797958971f * 1.4426950408889634f * 1.02f * gq_ * gk_;
          fixref = __builtin_amdgcn_readfirstlane((bound_ <= 80.0f) ? 1 : 0) != 0; }
        for (int uidx = vcu; uidx < NBATCH * 8 * 8; uidx += G) {
            const int qb = uidx & 7, bh = uidx >> 3, h = bh & 7, b = bh >> 3;
            const size_t r0 = (size_t)b * SEQ + qb * 512;
            if (fixref) ATT_MAIN(lds, Qf + r0 * 768 + h * 96, 768, Kf + (size_t)b * SEQ * 768 + h * 96, 768, VTb + (size_t)(h * 64) * MT + (size_t)b * SEQ, MT, SEQ, OB + r0 * 1024 + h * 64, 1024);
            else {
#pragma unroll 1
                for (int half = 0; half < 2; ++half) { const size_t r1 = r0 + half * 256;
                    attn_unit<96>(lds, Qf + r1 * 768 + h * 96, 768, Kf + (size_t)b * SEQ * 768 + h * 96, 768, VTb + (size_t)(h * 64) * MT + (size_t)b * SEQ, MT, SEQ, OB + r1 * 1024 + h * 64, 1024); } }
        }
#endif
#if (PH5M & 2)
        const bool deal_ = (G == 256);
        const int mu0_ = deal_ ? (bx < 64 ? 2 * bx : 128 + 6 * (bx - 64)) : vcu, mun_ = deal_ ? (bx < 64 ? 2 : 6) : (NBATCH * 4 * 16 - vcu + G - 1) / G, mus_ = deal_ ? 1 : G;
        for (int mi_ = 0; mi_ < mun_; ++mi_) { const int uidx = mu0_ + mi_ * mus_;
            const int qb = uidx & 15, bh = uidx >> 4, h = bh & 3, b = bh >> 2;
            const size_t r0 = (size_t)b * SEQ + qb * 256;
            attn_unit<64>(lds, MQ + r0 * 256 + h * 64, 256, MK + (size_t)b * MEMTOK * 256 + h * 64, 256, MVT + (size_t)(h * 64) * MMEM + (size_t)b * MEMTOK, MMEM, MEMTOK, OB + r0 * 1024 + 768 + h * 64, 1024);
        }
#endif
        __syncthreads();
#if (PH5M & 4)
        { pg8::Gemm g{Ure, BtY, 16 * SROWS, 16 * 1024, ULD, ULD, ULD}; BatchedOrder S{4, G, bx}; EpiY E{Ure, a.in[20], Yact}; run_gemm(lds, g, S, E); }
#endif
    }
    }
#endif
    xcd_barrier(xbar);

#if (PHM >> 6) & 1
    for (int rep_ = 0; rep_ < 1 + ((DUPM >> 6) & 1); ++rep_) { DECL_PTRS;
    { pg8::Gemm g{Yact, WgluT, MT, 256, 256, 256, 256}; pg8::StaticOrder S; S.init(MT, 256, G, bx); EpiGlu E{Yact, OB + 512, 1024}; run_gemm(lds, g, S, E); }
    }
#endif
    xcd_barrier(xbar);

#if (PHM >> 7) & 1
    for (int rep_ = 0; rep_ < 1 + ((DUPM >> 7) & 1); ++rep_) { DECL_PTRS;
    {
        { pg8::Gemm g{OB, WbT, MT, 1024, 1024, 1024, 1024, Gt}; pg8::StaticOrder S; S.init(MT, 1024, G, bx); EpiBranchF E{Gt, Merged}; run_gemm_hook(lds, g, S, E); }
    }
    }
#endif
    xcd_barrier(xbar);

#if (PHM >> 8) & 1
    for (int rep_ = 0; rep_ < 1 + ((DUPM >> 8) & 1); ++rep_) { DECL_PTRS;
    { pg8::Gemm g{Merged, WoutT, MT, 1024, 1024, 1024, 1024}; pg8::StaticOrder S; S.init(MT, 1024, G, bx); EpiOut E{xp, xs, a.out, H2, (float*)(ws + WS_RSS)}; run_gemm(lds, g, S, E); }
    }
#endif
    xcd_barrier(xbar);

#if (PHM >> 10) & 1
    for (int rep_ = 0; rep_ < 1 + ((DUPM >> 10) & 1); ++rep_) { DECL_PTRS;
    { pg8::Gemm g{H2, WguT, MT, 2 * FFD, 1024, 1024, 1024}; pg8::StaticOrder S; S.init(MT, 2 * FFD, G, bx); EpiSwiglu E{Act, (const float*)(ws + WS_RSS)}; run_gemm(lds, g, S, E); }
    }
#endif
    xcd_barrier(xbar);

#if (PHM >> 11) & 1
    for (int rep_ = 0; rep_ < 1 + ((DUPM >> 11) & 1); ++rep_) { DECL_PTRS;
    { pg8::Gemm g{Act, WdT, MT, 1024, FFD, FFD, FFD}; pg8::StaticOrder S; S.init(MT, 1024, G, bx); EpiDown E{a.out}; run_gemm(lds, g, S, E); }
    }
#endif
}

extern "C" void kernel_launch(void* const* d_in, const int* in_sizes, int n_in, void* d_out, int out_size, void* d_ws, size_t ws_size, hipStream_t stream) {
    static int grid = 0;
    if (grid == 0) {
        if (n_in != 33 || out_size != MT * DM || ws_size < WS_END) { fprintf(stderr, "kernel_launch: unexpected shapes (n_in %d, out %d, ws %zu)\n", n_in, out_size, ws_size); grid = -1; return; }
        int dev = 0, cus = 0, per_cu = 0;
        (void)hipGetDevice(&dev); (void)hipDeviceGetAttribute(&cus, hipDeviceAttributeMultiprocessorCount, dev);
        if (hipFuncSetAttribute((const void*)fwd_megakernel, hipFuncAttributeMaxDynamicSharedMemorySize, LDS_BYTES) != hipSuccess) { fprintf(stderr, "kernel_launch: hipFuncSetAttribute failed\n"); grid = -1; return; }
        if (hipOccupancyMaxActiveBlocksPerMultiprocessor(&per_cu, (const void*)fwd_megakernel, NTHR, LDS_BYTES) != hipSuccess || per_cu < 1) { fprintf(stderr, "kernel_launch: occupancy query says %d\n", per_cu); per_cu = 1; }
        (void)hipGetLastError();
        grid = cus;
    }
    if (grid < 0) return;
    Args a{};
    for (int i = 0; i < 33; ++i) a.in[i] = (const float*)d_in[i];
    a.out = (float*)d_out; a.ws = (unsigned char*)d_ws;
    (void)hipMemsetAsync((unsigned char*)d_ws + WS_BAR, 0, 16384, stream);
    void* args[] = {&a};
    hipError_t e = hipLaunchCooperativeKernel((const void*)fwd_megakernel, dim3(grid), dim3(NTHR), args, LDS_BYTES, stream);
    if (e != hipSuccess) fprintf(stderr, "kernel_launch: cooperative launch failed: %s (grid %d)\n", hipGetErrorString(e), grid);
}
```

```cpp
#include <hip/hip_runtime.h>
#include <hip/hip_cooperative_groups.h>
#include <cstdio>
#include <cstdint>
namespace cg = cooperative_groups;

#ifndef SLOW_GEMM
#define SLOW_GEMM 0
#endif
#ifndef SLOW_ATTN
#define SLOW_ATTN 0
#endif
#ifndef PHM
#define PHM 0xFFF
#endif
#ifndef PH5M
#define PH5M 7
#endif
#ifndef PH3M
#define PH3M 15
#endif
#ifndef DUPM
#define DUPM 0
#endif
#ifndef ATT_SCHED
#define ATT_SCHED 0
#endif
#ifndef EXTRA_SYNCS
#define EXTRA_SYNCS 0
#endif
#ifndef SHADOW_ATT
#define SHADOW_ATT 0
#endif
#ifndef ATT_PRIO
#define ATT_PRIO 1
#endif
#ifndef ATT_MAIN
#define ATT_MAIN attn_unit2
#endif
namespace pg8 {
#define PG8_LAS __attribute__((address_space(3)))
typedef unsigned short bf16_t;
typedef short bf16x8 __attribute__((ext_vector_type(8)));
typedef float f32x4 __attribute__((ext_vector_type(4)));
typedef unsigned u32x4 __attribute__((ext_vector_type(4)));
constexpr int BM = 256, BK = 64, HALF = 128, HTB = HALF * BK * 2  , STAGE_BYTES = 8 * HTB, NXCD = 8, WGM = 8;

__host__ __device__ __forceinline__ int lds_byte(int r, int c) { const int st = (r >> 4) * 2 + (c >> 5), rr = r & 15, cc = c & 31, ob = rr * 64 + cc * 2; return st * 1024 + (ob ^ (((ob >> 9) & 1) << 5)); }
__host__ __device__ __forceinline__ void stage_rc(int b, int& R, int& C) { const int st = b / 1024, sb = b % 1024, swz = sb ^ (((sb >> 9) & 1) << 5); R = (st >> 1) * 16 + swz / 64; C = (st & 1) * 32 + (swz % 64) / 2; }
__host__ __device__ __forceinline__ int perm32(int rho) { const int n = rho >> 4, i = rho & 15; return 8 * (i >> 2) + 4 * n + (i & 3); }

struct Unit { int pm, pn; };
struct Gemm { const bf16_t* A; const bf16_t* Bt; int M, N, K, lda, ldb; const bf16_t* hookG = nullptr; };

struct StaticOrder {
    int nM, nN, nwg, G, c;
    __host__ __device__ void init(int M, int N, int G_, int c_) { nM = M / BM; nN = N / BM; nwg = nM * nN; G = G_; c = c_; }
    __host__ __device__ bool next(int i, Unit& u) const {
        const long L = (long)i * G + c; if (L >= nwg) return false;
        int wgid = (int)L; { const int q = nwg / NXCD, r = nwg % NXCD, xcd = wgid % NXCD, off = wgid / NXCD; wgid = (xcd < r ? xcd * (q + 1) : r * (q + 1) + (xcd - r) * q) + off; }
        const int nig = WGM * nN, gid = wgid / nig, fm = gid * WGM, gsz = (nM - fm) < WGM ? (nM - fm) : WGM;
        u.pm = fm + ((wgid % nig) % gsz); u.pn = (wgid % nig) / gsz; return true;
    }
    __device__ __forceinline__ void a_ready(const Unit&) const {}
    __device__ __forceinline__ void done(const Unit&) const {}
};

__device__ __forceinline__ unsigned cvt_pk_bf16(float lo, float hi) { unsigned r; asm volatile("v_cvt_pk_bf16_f32 %0, %1, %2" : "=v"(r) : "v"(lo), "v"(hi)); return r; }
typedef float f32x2 __attribute__((ext_vector_type(2)));

template <class E> __device__ __forceinline__ void run_epi(const E& e, const f32x4 (&acc)[2][2][4][2], const Unit& u, int wr, int wc, int fr, int fq) {
    asm volatile("" : "+v"(fr), "+v"(fq));
#pragma unroll
    for (int ai = 0; ai < 2; ++ai)
#pragma unroll
        for (int m = 0; m < 4; ++m) { const int row = u.pm * BM + ai * HALF + wr * 64 + m * 16 + fr;
#pragma unroll
            for (int bj = 0; bj < 2; ++bj) { const int col = u.pn * BM + bj * HALF + wc * 32 + (E::PERM ? 8 : 4) * fq; e.apply2(row, col, acc[ai][bj][m][0], acc[ai][bj][m][1]); }
            asm volatile("" ::: "memory"); }
}

template <class Epi, class Sched, bool ALIGN_EPI = false, bool SP2 = false, bool HOOK = false>
__device__ __forceinline__ void gemm_phase(PG8_LAS unsigned char* lds, const Gemm g, const Sched& S, const Epi& E) {
    int tid_l = threadIdx.x; asm volatile("" : "+v"(tid_l));
    const int tid = tid_l, wid = __builtin_amdgcn_readfirstlane(tid >> 6), lane = tid & 63, wr = wid >> 2, wc = wid & 3, fr = lane & 15, fq = lane >> 4;
    const int K = g.K, nt = K / BK;
    unsigned voffA[2], voffB[2];
#pragma unroll
    for (int i = 0; i < 2; ++i) { int R, C; stage_rc(tid * 16 + i * 8192, R, C); const int Rb = Epi::PERM ? ((R & ~31) + perm32(R & 31)) : R;
        voffA[i] = (unsigned)(R * g.lda + C) * 2u; voffB[i] = (unsigned)(Rb * g.ldb + C) * 2u; }
    const size_t kstep = (size_t)(BK * 2);
    const size_t hstepA = (size_t)HALF * g.lda * 2, hstepB = (size_t)HALF * g.ldb * 2;
    const size_t tstepA = 2 * hstepA, tstepB = 2 * hstepB;
    const unsigned ldsw = (unsigned)wid * 1024u;
    const int aoff = lds_byte(wr * 64 + fr, fq * 8), boff = lds_byte(wc * 32 + fr, fq * 8);
#define PG8_SA(b, h) (((b) * 2 + (h)) * HTB)
#define PG8_SB(b, h) ((4 + (b) * 2 + (h)) * HTB)
#define PG8_STAGE(bufoff, gbase, voff) do { _Pragma("unroll") for (int _i = 0; _i < 2; ++_i) \
        __builtin_amdgcn_global_load_lds((const unsigned*)((const char*)(gbase) + (voff)[_i]), (PG8_LAS unsigned*)(lds + (bufoff) + ldsw + _i * 8192), 16, 0, 0); } while (0)
#define PG8_LDA(dst, b, h) do { _Pragma("unroll") for (int m = 0; m < 4; ++m) _Pragma("unroll") for (int k = 0; k < 2; ++k) dst[m][k] = *(const PG8_LAS bf16x8*)(lds + PG8_SA(b, h) + aoff + m * 2048 + k * 1024); } while (0)
#define PG8_LDB(dst, b, h) do { _Pragma("unroll") for (int n = 0; n < 2; ++n) _Pragma("unroll") for (int k = 0; k < 2; ++k) dst[n][k] = *(const PG8_LAS bf16x8*)(lds + PG8_SB(b, h) + boff + n * 2048 + k * 1024); } while (0)
#define PG8_MMA(ai, bj, At, Bt) do { __builtin_amdgcn_s_setprio(1); _Pragma("unroll") for (int m = 0; m < 4; ++m) _Pragma("unroll") for (int n = 0; n < 2; ++n) _Pragma("unroll") for (int k = 0; k < 2; ++k) \
        acc[ai][bj][m][n] = __builtin_amdgcn_mfma_f32_16x16x32_bf16(Bt[n][k], At[m][k], acc[ai][bj][m][n], 0, 0, 0); __builtin_amdgcn_s_setprio(0); } while (0)
#define PG8_WAIT_V(n) asm volatile("s_waitcnt vmcnt(" #n ")" ::: "memory")
#define PG8_WAIT_L(n) asm volatile("s_waitcnt lgkmcnt(" #n ")" ::: "memory")
#define PG8_BAR __builtin_amdgcn_s_barrier()
#define PG8_SCHED __builtin_amdgcn_sched_barrier(0)
    Unit cur, nxt; int ui = 0;
    if (!S.next(0, cur)) return;
    f32x4 acc[2][2][4][2];
#pragma unroll
    for (int a = 0; a < 2; ++a)
#pragma unroll
        for (int b = 0; b < 2; ++b)
#pragma unroll
            for (int m = 0; m < 4; ++m)
#pragma unroll
                for (int n = 0; n < 2; ++n) acc[a][b][m][n] = (f32x4){0.f, 0.f, 0.f, 0.f};
    bf16x8 At[4][2], B0[2][2], B1[2][2];
    const char* cA = (const char*)g.A + (size_t)cur.pm * tstepA; const char* cB = (const char*)g.Bt + (size_t)cur.pn * tstepB;
    S.a_ready(cur);
    if constexpr (SP2) {
        PG8_STAGE(PG8_SB(0, 0), cB, voffB); PG8_STAGE(PG8_SB(0, 1), cB + hstepB, voffB); PG8_STAGE(PG8_SA(0, 0), cA, voffA); PG8_STAGE(PG8_SA(0, 1), cA + hstepA, voffA);
        if (wr == 1) PG8_BAR;
        PG8_WAIT_V(2); PG8_BAR;
        PG8_STAGE(PG8_SB(1, 0), cB + kstep, voffB); PG8_STAGE(PG8_SA(1, 0), cA + kstep, voffA); PG8_STAGE(PG8_SB(1, 1), cB + hstepB + kstep, voffB);
        PG8_WAIT_V(6); PG8_BAR;
    } else {
        PG8_STAGE(PG8_SB(0, 0), cB, voffB); PG8_STAGE(PG8_SA(0, 0), cA, voffA); PG8_STAGE(PG8_SB(0, 1), cB + hstepB, voffB); PG8_STAGE(PG8_SA(0, 1), cA + hstepA, voffA);
        if (wr == 1) PG8_BAR;
        PG8_WAIT_V(4); PG8_BAR;
        PG8_STAGE(PG8_SB(1, 0), cB + kstep, voffB); PG8_STAGE(PG8_SA(1, 0), cA + kstep, voffA); PG8_STAGE(PG8_SB(1, 1), cB + hstepB + kstep, voffB);
        PG8_WAIT_V(6); PG8_BAR;
    }
    for (;;) {
        const bool has_next = S.next(ui + 1, nxt);
        const char* nA = has_next ? (const char*)g.A + (size_t)nxt.pm * tstepA : cA; const char* nB = has_next ? (const char*)g.Bt + (size_t)nxt.pn * tstepB : cB;
        for (int t = 0; t < nt; t += 2) {
            if constexpr (HOOK) {
                if (t == 8 || t == 12) {
                    int fr2 = fr, fq2 = fq; asm volatile("" : "+v"(fr2), "+v"(fq2));
                    const int sa = (t == 8) ? 0 : 1024;
#pragma unroll
                    for (int ai = 0; ai < 2; ++ai)
#pragma unroll
                        for (int m = 0; m < 4; ++m) { const int row = cur.pm * BM + ai * HALF + wr * 64 + m * 16 + fr2;
#pragma unroll
                            for (int bj = 0; bj < 2; ++bj) { const int col = cur.pn * BM + bj * HALF + wc * 32 + 8 * fq2;
                                const bf16_t* gp = g.hookG + (size_t)row * 3072 + sa + col;
                                const u32x4 wa = *(const u32x4*)gp, wb = *(const u32x4*)(gp + 1024);
                                f32x4 r0, r1;
#define PG8_RAT(wa_, wb_, hi_) ((hi_ ? __builtin_bit_cast(float, (wa_) & 0xffff0000u) : __builtin_bit_cast(float, (wa_) << 16)) * __builtin_amdgcn_rcpf(__builtin_fmaxf(hi_ ? __builtin_bit_cast(float, (wb_) & 0xffff0000u) : __builtin_bit_cast(float, (wb_) << 16), 1e-20f)))
                                r0[0] = PG8_RAT(wa.x, wb.x, 0); r0[1] = PG8_RAT(wa.x, wb.x, 1); r0[2] = PG8_RAT(wa.y, wb.y, 0); r0[3] = PG8_RAT(wa.y, wb.y, 1);
                                r1[0] = PG8_RAT(wa.z, wb.z, 0); r1[1] = PG8_RAT(wa.z, wb.z, 1); r1[2] = PG8_RAT(wa.w, wb.w, 0); r1[3] = PG8_RAT(wa.w, wb.w, 1);
#undef PG8_RAT
                                acc[ai][bj][m][0] *= r0; acc[ai][bj][m][1] *= r1; }
                            asm volatile("" ::: "memory"); }
                }
            }
            const bool last = (t == nt - 2);
            const char* a1 = cA + (size_t)(t + 1) * kstep;
            const char* a2 = last ? nA : cA + (size_t)(t + 2) * kstep; const char* b2 = last ? nB : cB + (size_t)(t + 2) * kstep;
            const char* a3 = a2 + kstep; const char* b3 = b2 + kstep;
            if (last && has_next) S.a_ready(nxt);
            if constexpr (SP2) {
            PG8_LDB(B0, 0, 0); PG8_LDB(B1, 0, 1); PG8_SCHED; PG8_LDA(At, 0, 0); PG8_STAGE(PG8_SA(1, 1), a1 + hstepA, voffA);
            PG8_WAIT_V(8); PG8_WAIT_L(0); PG8_BAR; PG8_MMA(0, 0, At, B0); PG8_MMA(0, 1, At, B1); PG8_BAR; PG8_SCHED;
            PG8_LDA(At, 0, 1); PG8_STAGE(PG8_SB(0, 0), b2, voffB); PG8_STAGE(PG8_SB(0, 1), b2 + hstepB, voffB); PG8_STAGE(PG8_SA(0, 0), a2, voffA);
            PG8_WAIT_V(8); PG8_WAIT_L(0); PG8_BAR; PG8_MMA(1, 0, At, B0); PG8_MMA(1, 1, At, B1); PG8_BAR; PG8_SCHED;
            PG8_LDB(B0, 1, 0); PG8_LDB(B1, 1, 1); PG8_SCHED; PG8_LDA(At, 1, 0); PG8_STAGE(PG8_SA(0, 1), a2 + hstepA, voffA);
            PG8_WAIT_V(8); PG8_WAIT_L(0); PG8_BAR; PG8_MMA(0, 0, At, B0); PG8_MMA(0, 1, At, B1); PG8_BAR; PG8_SCHED;
            PG8_LDA(At, 1, 1); PG8_STAGE(PG8_SB(1, 0), b3, voffB); PG8_STAGE(PG8_SB(1, 1), b3 + hstepB, voffB); PG8_STAGE(PG8_SA(1, 0), a3, voffA);
            PG8_WAIT_V(8); PG8_WAIT_L(0); PG8_BAR; PG8_MMA(1, 0, At, B0); PG8_MMA(1, 1, At, B1); PG8_BAR; PG8_SCHED;
            } else {
            PG8_LDB(B0, 0, 0); PG8_SCHED; PG8_LDA(At, 0, 0); PG8_STAGE(PG8_SA(1, 1), a1 + hstepA, voffA);
            PG8_WAIT_L(8); PG8_BAR; PG8_WAIT_L(0); PG8_MMA(0, 0, At, B0); PG8_BAR; PG8_SCHED;
            PG8_LDB(B1, 0, 1); PG8_STAGE(PG8_SB(0, 0), b2, voffB);
            PG8_BAR; PG8_WAIT_L(0); PG8_MMA(0, 1, At, B1); PG8_BAR;
            PG8_LDA(At, 0, 1); PG8_STAGE(PG8_SA(0, 0), a2, voffA);
            PG8_BAR; PG8_WAIT_L(0); PG8_MMA(1, 0, At, B0); PG8_BAR; PG8_SCHED;
            PG8_STAGE(PG8_SB(0, 1), b2 + hstepB, voffB);
            PG8_WAIT_V(6); PG8_BAR; PG8_MMA(1, 1, At, B1); PG8_BAR;
            PG8_LDB(B0, 1, 0); PG8_SCHED; PG8_LDA(At, 1, 0); PG8_STAGE(PG8_SA(0, 1), a2 + hstepA, voffA);
            PG8_WAIT_L(8); PG8_BAR; PG8_WAIT_L(0); PG8_MMA(0, 0, At, B0); PG8_BAR; PG8_SCHED;
            PG8_LDB(B1, 1, 1); PG8_STAGE(PG8_SB(1, 0), b3, voffB);
            PG8_BAR; PG8_WAIT_L(0); PG8_MMA(0, 1, At, B1); PG8_BAR;
            PG8_LDA(At, 1, 1); PG8_STAGE(PG8_SA(1, 0), a3, voffA);
            PG8_BAR; PG8_WAIT_L(0); PG8_MMA(1, 0, At, B0); PG8_BAR; PG8_SCHED;
            PG8_STAGE(PG8_SB(1, 1), b3 + hstepB, voffB);
            PG8_WAIT_V(6); PG8_BAR; PG8_MMA(1, 1, At, B1); PG8_BAR;
            }
        }
        if constexpr (ALIGN_EPI) { if (wr == 0) PG8_BAR; }
        if constexpr (!Epi::AFTER_DRAIN) { run_epi(E, acc, cur, wr, wc, fr, fq); S.done(cur); }
        if (!has_next) break;
#pragma unroll
        for (int a = 0; a < 2; ++a)
#pragma unroll
            for (int b = 0; b < 2; ++b)
#pragma unroll
                for (int m = 0; m < 4; ++m)
#pragma unroll
                    for (int n = 0; n < 2; ++n) acc[a][b][m][n] = (f32x4){0.f, 0.f, 0.f, 0.f};
        cur = nxt; cA = nA; cB = nB; ++ui;
        if constexpr (ALIGN_EPI) { if (wr == 1) PG8_BAR; }
    }
    PG8_WAIT_V(0);
    if constexpr (!ALIGN_EPI) { if (wr == 0) PG8_BAR; }
    PG8_BAR;
    if constexpr (Epi::AFTER_DRAIN) { E.fused(acc, cur, wr, wc, fr, fq, lds, wid, lane); S.done(cur); }
#undef PG8_SA
#undef PG8_SB
#undef PG8_STAGE
#undef PG8_LDA
#undef PG8_LDB
#undef PG8_MMA
#undef PG8_WAIT_V
#undef PG8_WAIT_L
#undef PG8_BAR
#undef PG8_SCHED
}
}

#define GAS __attribute__((address_space(1)))
#define LAS __attribute__((address_space(3)))
typedef unsigned short bf16;
typedef unsigned v4u __attribute__((ext_vector_type(4)));
typedef unsigned v2u __attribute__((ext_vector_type(2)));
typedef float f32x4 __attribute__((ext_vector_type(4)));
typedef float f32x16 __attribute__((ext_vector_type(16)));
typedef short bf16x8 __attribute__((ext_vector_type(8)));

constexpr int NBATCH = 20, NPROMPT = 4, SEQ = 4096, MT = NBATCH * SEQ, DM = 1024;
constexpr int MROWS_P = NPROMPT * SEQ;
constexpr int MEMTOK = 256, MMEM = NBATCH * MEMTOK;
constexpr int NZ = 4352, NZS = 1280, NG = 3072, FFD = 2816;
constexpr float EPS = 1e-6f, LOG2E = 1.4426950408889634f;
constexpr float QSCALE = 0.10206207261596575f * LOG2E;
constexpr float MQSCALE = 0.125f * LOG2E;
constexpr int NWAVES = 8, NTHR = 512;
constexpr int CH = 64, NCHUNK = SEQ / CH, SROWS = NBATCH * NCHUNK;
constexpr int ULD = 1280;

constexpr size_t MiB = 1u << 20;
constexpr size_t WS_WIN = 0;
constexpr size_t WS_WUQ = WS_WIN + (size_t)NZ * 1024 * 2;
constexpr size_t WS_WUKV = WS_WUQ + (size_t)768 * 384 * 2;
constexpr size_t WS_WGLU = WS_WUKV + (size_t)1024 * 256 * 2;
constexpr size_t WS_WMKV = WS_WGLU + (size_t)256 * 256 * 2;
constexpr size_t WS_WB = WS_WMKV + (size_t)512 * 1024 * 2;
constexpr size_t WS_WOUT = WS_WB + (size_t)1024 * 1024 * 2;
constexpr size_t WS_WGU = WS_WOUT + (size_t)1024 * 1024 * 2;
constexpr size_t WS_WD = WS_WGU + (size_t)5632 * 1024 * 2;
constexpr size_t WS_WEND = WS_WD + (size_t)1024 * 2816 * 2;
static_assert(WS_WEND <= 40 * MiB, "weights");
constexpr size_t WS_BTY = 40 * MiB;
constexpr size_t WS_BST = 80 * MiB;
constexpr size_t WS_SM = 88 * MiB;
constexpr size_t WS_RQ = WS_SM;
constexpr size_t WS_RKV = WS_RQ + (size_t)MT * 4;
constexpr size_t WS_MK = WS_RKV + (size_t)MT * 4;
constexpr size_t WS_MVT = WS_MK + (size_t)MMEM * 256 * 2;
constexpr size_t WS_KLAG = WS_MVT + (size_t)MMEM * 256 * 2;
static_assert(WS_KLAG + 2 * MiB <= 100 * MiB, "small");
constexpr size_t WS_MQ = 100 * MiB;
constexpr size_t WS_URE = 140 * MiB;
constexpr size_t WS_SST = 190 * MiB;
constexpr size_t WS_MERGED = 40 * MiB;
constexpr size_t WS_ZS = 210 * MiB;
constexpr size_t WS_OB = WS_ZS;
constexpr size_t WS_YACT = WS_ZS + 160 * MiB;
constexpr size_t WS_H2 = WS_ZS;
constexpr size_t WS_G = 410 * MiB;
constexpr size_t WS_ACT = WS_G;
constexpr size_t WS_BAR = 890 * MiB;
constexpr size_t WS_RSS = 890 * MiB + 65536;
constexpr size_t WS_END = 891 * MiB;
constexpr size_t DO_XN = 0;
constexpr size_t DO_MEMN = 160 * MiB;
constexpr size_t DO_QF = 0;
constexpr size_t DO_KF = 120 * MiB;
constexpr size_t DO_VT = 240 * MiB;

constexpr int LDS_BYTES = 147456;

#define LDS_WAIT() asm volatile("s_waitcnt lgkmcnt(0)" ::: "memory")
__device__ __forceinline__ unsigned f2bf(float f) { unsigned u = __builtin_bit_cast(unsigned, f); return (u + 0x7fffu + ((u >> 16) & 1u)) >> 16; }
typedef float f32x2_t __attribute__((ext_vector_type(2))); typedef __bf16 bf16x2_t __attribute__((ext_vector_type(2)));
__device__ __forceinline__ unsigned pk2(float lo, float hi) { f32x2_t v = {lo, hi}; bf16x2_t b = __builtin_convertvector(v, bf16x2_t); return __builtin_bit_cast(unsigned, b); }
__device__ __forceinline__ float bflo(unsigned w) { return __builtin_bit_cast(float, w << 16); }
__device__ __forceinline__ float bfhi(unsigned w) { return __builtin_bit_cast(float, w & 0xffff0000u); }
__device__ __forceinline__ float wave_sum(float v) {
#pragma unroll
    for (int o = 1; o < 64; o <<= 1) v += __shfl_xor(v, o);
    return v;
}
__device__ __forceinline__ float sumsq8(v4u p) {
    float a = bflo(p.x), b = bfhi(p.x), c = bflo(p.y), d = bfhi(p.y), e = bflo(p.z), f = bfhi(p.z), g = bflo(p.w), h = bfhi(p.w);
    return ((a * a + b * b) + (c * c + d * d)) + ((e * e + f * f) + (g * g + h * h));
}
__device__ __forceinline__ float sigmoidf_(float x) { return __builtin_amdgcn_rcpf(1.0f + __builtin_amdgcn_exp2f(-1.4426950408889634f * x)); }
__device__ __forceinline__ float gelu_tanh(float x) { const float u = 1.5957691216057308f * (x + 0.044715f * x * x * x); return x * __builtin_amdgcn_rcpf(1.0f + __builtin_amdgcn_exp2f(-1.4426950408889634f * u)); }
__device__ __forceinline__ const float* xrow_ptr(const float* xp, const float* xs, int m) { return m < MROWS_P ? xp + (size_t)m * DM : xs + (size_t)(m - MROWS_P) * DM; }

__device__ __forceinline__ void cpowk(float lre, float lim, float dt, int k, float& pr, float& pi) {
    const float mag = expf((float)k * lre * dt);
    double rev = (double)k * (double)lim * (double)dt * 0.15915494309189535;
    rev -= floor(rev);
    const float fr = (float)rev;
    pr = mag * __builtin_amdgcn_cosf(fr); pi = mag * __builtin_amdgcn_sinf(fr);
}
__device__ __forceinline__ void zcoef(float lre, float lim, float dt, float& zr, float& zi) {
    float ar, ai; cpowk(lre, lim, dt, 1, ar, ai);
    const float den = lre * lre + lim * lim, nre = ar - 1.0f;
    zr = (nre * lre + ai * lim) / den; zi = (ai * lre - nre * lim) / den;
}

template <class Epi, class Sched>
__device__ __forceinline__ void run_gemm(LAS unsigned char* lds, const pg8::Gemm g, const Sched& S, const Epi& E) {
    pg8::gemm_phase<Epi, Sched, true, true>(lds, g, S, E);
}
template <class Epi, class Sched>
__device__ __forceinline__ void run_gemm_hook(LAS unsigned char* lds, const pg8::Gemm g, const Sched& S, const Epi& E) {
    pg8::gemm_phase<Epi, Sched, true, true, true>(lds, g, S, E);
}
template <class Epi, class Sched>
__device__ __forceinline__ void run_gemm4(LAS unsigned char* lds, const pg8::Gemm g, const Sched& S, const Epi& E) {
    pg8::gemm_phase<Epi, Sched, true, false>(lds, g, S, E);
}

struct BatchedOrder {
    int npg, G, c;
    __device__ bool next(int i, pg8::Unit& u) const {
        const int L = i * G + c; if (L >= 80 * npg) return false;
        u.pm = L / npg; u.pn = (u.pm / 5) * npg + (L % npg); return true;
    }
    __device__ __forceinline__ void a_ready(const pg8::Unit&) const {}
    __device__ __forceinline__ void done(const pg8::Unit&) const {}
};

#define EPI_FLAGS static constexpr bool PERM = true, AFTER_DRAIN = false;
__device__ __forceinline__ void st_bf8(bf16* p, f32x4 a, f32x4 b) { v4u w; w.x = pk2(a[0], a[1]); w.y = pk2(a[2], a[3]); w.z = pk2(b[0], b[1]); w.w = pk2(b[2], b[3]); *(v4u*)p = w; }
__device__ __forceinline__ void st_bf4(bf16* p, f32x4 v) { v2u w; w.x = pk2(v[0], v[1]); w.y = pk2(v[2], v[3]); *(v2u*)p = w; }
__device__ __forceinline__ void ld_bf8(const bf16* p, f32x4& a, f32x4& b) { const v4u w = *(const v4u*)p; a = (f32x4){bflo(w.x), bfhi(w.x), bflo(w.y), bfhi(w.y)}; b = (f32x4){bflo(w.z), bfhi(w.z), bflo(w.w), bfhi(w.w)}; }
__device__ __forceinline__ f32x4 sig4(f32x4 v) { f32x4 s; s[0] = sigmoidf_(v[0]); s[1] = sigmoidf_(v[1]); s[2] = sigmoidf_(v[2]); s[3] = sigmoidf_(v[3]); return s; }

struct EpiZ { EPI_FLAGS bf16* Zs; bf16* G;
    __device__ __forceinline__ void apply2(int row, int col, f32x4 v0, f32x4 v1) const {
        if (col < NZS) st_bf8(Zs + (size_t)row * NZS + col, v0, v1);
        else st_bf8(G + (size_t)row * NG + (col - NZS), sig4(v0), sig4(v1)); } };

struct EpiStore { EPI_FLAGS bf16* O; int ld;
    __device__ __forceinline__ void apply2(int row, int col, f32x4 v0, f32x4 v1) const { st_bf8(O + (size_t)row * ld + col, v0, v1); } };

struct EpiRowScale { EPI_FLAGS bf16* O; int ld; const float* rs;
    __device__ __forceinline__ void apply2(int row, int col, f32x4 v0, f32x4 v1) const { const float r = rs[row]; st_bf8(O + (size_t)row * ld + col, v0 * r, v1 * r); } };

struct EpiKnope { EPI_FLAGS bf16* Kf;
    __device__ __forceinline__ void apply2(int row, int col, f32x4 v0, f32x4 v1) const { const int c0 = (col >> 6) * 96 + (col & 63);
        st_bf8(Kf + (size_t)row * 768 + c0, v0, v1); } };

struct EpiColScale { EPI_FLAGS bf16* O; int ld; const float* cs;
    __device__ __forceinline__ void apply2(int row, int col, f32x4 v0, f32x4 v1) const {
        const f32x4 s0 = *(const f32x4*)(cs + col), s1 = *(const f32x4*)(cs + col + 4);
        st_bf8(O + (size_t)row * ld + col, v0 * s0, v1 * s1); } };

struct EpiSst { EPI_FLAGS float* S;
    __device__ __forceinline__ void apply2(int row, int col, f32x4 v0, f32x4 v1) const { const int c = col & 255; *(f32x4*)(S + (size_t)row * 256 + c) = v0; *(f32x4*)(S + (size_t)row * 256 + c + 4) = v1; } };

struct EpiY { EPI_FLAGS const bf16* Ure; const float* dvec; bf16* Yact;
    __device__ __forceinline__ void apply2(int row, int colg, f32x4 v0, f32x4 v1) const {
        const int g = row / SROWS, col = colg & 1023, t = col >> 4, h0 = col & 15;
        const int m = (row - g * SROWS) * CH + t, ch = g * 16 + h0;
        f32x4 u0, u1; ld_bf8(Ure + (size_t)row * ULD + col, u0, u1);
        const f32x4 d0 = *(const f32x4*)(dvec + ch), d1 = *(const f32x4*)(dvec + ch + 4);
        f32x4 y0 = v0 + d0 * u0, y1 = v1 + d1 * u1;
        y0[0] = gelu_tanh(y0[0]); y0[1] = gelu_tanh(y0[1]); y0[2] = gelu_tanh(y0[2]); y0[3] = gelu_tanh(y0[3]);
        y1[0] = gelu_tanh(y1[0]); y1[1] = gelu_tanh(y1[1]); y1[2] = gelu_tanh(y1[2]); y1[3] = gelu_tanh(y1[3]);
        st_bf8(Yact + (size_t)m * 256 + ch, y0, y1); } };

struct EpiGlu { EPI_FLAGS const bf16* Yact; bf16* Ossm; int ld;
    __device__ __forceinline__ void apply2(int row, int col, f32x4 v0, f32x4 v1) const { f32x4 y0, y1; ld_bf8(Yact + (size_t)row * 256 + col, y0, y1);
        st_bf8(Ossm + (size_t)row * ld + col, y0 * sig4(v0), y1 * sig4(v1)); } };

struct EpiBranchF { EPI_FLAGS const bf16* G; bf16* Mg;
    __device__ __forceinline__ void apply2(int row, int col, f32x4 v0, f32x4 v1) const { f32x4 g0, g1; ld_bf8(G + (size_t)row * NG + 2048 + col, g0, g1);
        st_bf8(Mg + (size_t)row * 1024 + col, g0 * v0, g1 * v1); } };

struct EpiOut { EPI_FLAGS const float* xp; const float* xs; float* out; bf16* X1b; float* rss;
    __device__ __forceinline__ void apply2(int row, int col, f32x4 v0, f32x4 v1) const { const float* xr = xrow_ptr(xp, xs, row) + col; float* o = out + (size_t)row * DM + col;
        const f32x4 a0 = *(const f32x4*)xr + v0, a1 = *(const f32x4*)(xr + 4) + v1;
        *(f32x4*)o = a0; *(f32x4*)(o + 4) = a1; st_bf8(X1b + (size_t)row * DM + col, a0, a1);
        float ss = ((a0[0] * a0[0] + a0[1] * a0[1]) + (a0[2] * a0[2] + a0[3] * a0[3])) + ((a1[0] * a1[0] + a1[1] * a1[1]) + (a1[2] * a1[2] + a1[3] * a1[3]));
        ss += __shfl_xor(ss, 16); ss += __shfl_xor(ss, 32);
        if (((threadIdx.x >> 4) & 3) == 0) unsafeAtomicAdd(rss + row, ss); } };

struct EpiSwiglu { EPI_FLAGS bf16* Act; const float* rss;
    __device__ __forceinline__ void apply2(int row, int col, f32x4 v0, f32x4 v1) const { const int c = col >> 1; const float r = 1.0f / sqrtf(rss[row] * (1.f / DM) + EPS);
        const f32x4 gt = v0 * r, up = v1 * r;
        st_bf4(Act + (size_t)row * FFD + c, gt * sig4(gt) * up); } };

struct EpiDown { EPI_FLAGS float* out;
    __device__ __forceinline__ void apply2(int row, int col, f32x4 v0, f32x4 v1) const { float* o = out + (size_t)row * DM + col; *(f32x4*)o = *(const f32x4*)o + v0; *(f32x4*)(o + 4) = *(const f32x4*)(o + 4) + v1; } };

template <class RowMap>
__device__ __forceinline__ void transpose_item(const float* W, int K, int N, bf16* WT, int ldw, const RowMap rm, const float* kscale, LAS float* scr, int item, int lane) {
    const int nblk = N / 32, kb = item / nblk, nb = item % nblk, k0 = 64 * kb, n0 = 32 * nb;
    float wv[32];
#pragma unroll
    for (int i = 0; i < 32; ++i) wv[i] = W[(size_t)(k0 + 2 * i + (lane >> 5)) * N + n0 + (lane & 31)];
#pragma unroll
    for (int i = 0; i < 32; ++i) { const int kk = 2 * i + (lane >> 5); float v = wv[i]; if (kscale) v *= kscale[k0 + kk]; scr[kk * 33 + (lane & 31)] = v; }
    LDS_WAIT(); asm volatile("" ::: "memory");
    const int c = lane & 7;
#pragma unroll
    for (int j = 0; j < 4; ++j) { const int n = (lane >> 3) + 8 * j; const LAS float* s = scr + (8 * c) * 33 + n;
        v4u o; o.x = pk2(s[0 * 33], s[1 * 33]); o.y = pk2(s[2 * 33], s[3 * 33]); o.z = pk2(s[4 * 33], s[5 * 33]); o.w = pk2(s[6 * 33], s[7 * 33]);
        *(v4u*)(WT + (size_t)rm(n0 + n) * ldw + k0 + 8 * c) = o; }
    LDS_WAIT(); asm volatile("" ::: "memory");
}
struct RmId { __device__ __forceinline__ int operator()(int n) const { return n; } };
struct RmWin { __device__ __forceinline__ int operator()(int n) const { return n < 672 ? n : n + 96; } };
struct RmUkv { __device__ __forceinline__ int operator()(int n) const { const int h = n >> 7, r = n & 127; return (r < 64 ? 0 : 512) + h * 64 + (r & 63); } };
struct RmGate { __device__ __forceinline__ int operator()(int n) const { return 8 * (n >> 2) + (n & 3); } };
struct RmUp { __device__ __forceinline__ int operator()(int n) const { return 8 * (n >> 2) + 4 + (n & 3); } };

__device__ __forceinline__ void rms_row_to_bf16(const float* xrow, const float* gain, bf16* orow, int lane) {
    const f32x4* xr = (const f32x4*)xrow + lane; const f32x4* gr = (const f32x4*)gain + lane;
    f32x4 v[4]; float s = 0.f;
#pragma unroll
    for (int j = 0; j < 4; ++j) { v[j] = xr[64 * j]; s += (v[j].x * v[j].x + v[j].y * v[j].y) + (v[j].z * v[j].z + v[j].w * v[j].w); }
    const float rstd = 1.0f / sqrtf(wave_sum(s) * (1.f / DM) + EPS);
    unsigned long long* o8 = (unsigned long long*)orow + lane;
#pragma unroll
    for (int j = 0; j < 4; ++j) { const f32x4 gg = gr[64 * j]; o8[64 * j] = (unsigned long long)pk2(v[j].x * rstd * gg.x, v[j].y * rstd * gg.y) | ((unsigned long long)pk2(v[j].z * rstd * gg.z, v[j].w * rstd * gg.w) << 32); }
}

__device__ __forceinline__ void rms_rows2_to_bf16(const float* xrow0, const float* xrow1, const float* gain, bf16* orow0, bf16* orow1, int lane) {
    const f32x4* xr0 = (const f32x4*)xrow0 + lane; const f32x4* xr1 = (const f32x4*)xrow1 + lane; const f32x4* gr = (const f32x4*)gain + lane;
    f32x4 v0[4], v1[4]; float s0 = 0.f, s1 = 0.f;
#pragma unroll
    for (int j = 0; j < 4; ++j) { v0[j] = xr0[64 * j]; v1[j] = xr1[64 * j]; }
#pragma unroll
    for (int j = 0; j < 4; ++j) { s0 += (v0[j].x * v0[j].x + v0[j].y * v0[j].y) + (v0[j].z * v0[j].z + v0[j].w * v0[j].w); s1 += (v1[j].x * v1[j].x + v1[j].y * v1[j].y) + (v1[j].z * v1[j].z + v1[j].w * v1[j].w); }
    const float r0 = 1.0f / sqrtf(wave_sum(s0) * (1.f / DM) + EPS), r1 = 1.0f / sqrtf(wave_sum(s1) * (1.f / DM) + EPS);
    unsigned long long* o0 = (unsigned long long*)orow0 + lane; unsigned long long* o1 = (unsigned long long*)orow1 + lane;
#pragma unroll
    for (int j = 0; j < 4; ++j) { const f32x4 gg = gr[64 * j];
        o0[64 * j] = (unsigned long long)pk2(v0[j].x * r0 * gg.x, v0[j].y * r0 * gg.y) | ((unsigned long long)pk2(v0[j].z * r0 * gg.z, v0[j].w * r0 * gg.w) << 32);
        o1[64 * j] = (unsigned long long)pk2(v1[j].x * r1 * gg.x, v1[j].y * r1 * gg.y) | ((unsigned long long)pk2(v1[j].z * r1 * gg.z, v1[j].w * r1 * gg.w) << 32); }
}

__device__ const double kRopeRev[16] = {
    0.15915494309189535, 0.08949959670338732, 0.05032921210448704, 0.028302217328425758,
    0.015915494309189534, 0.008949959670338732, 0.005032921210448704, 0.0028302217328425756,
    0.0015915494309189536, 0.0008949959670338732, 0.0005032921210448704, 0.00028302217328425755,
    0.00015915494309189535, 8.949959670338732e-05, 5.032921210448704e-05, 2.8302217328425757e-05 };

__device__ __forceinline__ v4u scale_piece(v4u p, float r, const float* gp) {
    const f32x4 g0 = *(const f32x4*)gp, g1 = *(const f32x4*)(gp + 4); v4u o;
    o.x = pk2(bflo(p.x) * r * g0[0], bfhi(p.x) * r * g0[1]); o.y = pk2(bflo(p.y) * r * g0[2], bfhi(p.y) * r * g0[3]);
    o.z = pk2(bflo(p.z) * r * g1[0], bfhi(p.z) * r * g1[1]); o.w = pk2(bflo(p.w) * r * g1[2], bfhi(p.w) * r * g1[3]); return o;
}
__device__ __forceinline__ void rope_pair(unsigned& w1, unsigned& w2, float r, float scale, const float* g1p, const float* g2p, int pos, int j) {
    float a0 = bflo(w1) * r * g1p[0], a1 = bfhi(w1) * r * g1p[1], b0 = bflo(w2) * r * g2p[0], b1 = bfhi(w2) * r * g2p[1];
    double rev0 = (double)pos * kRopeRev[j]; rev0 -= floor(rev0); const float f0 = (float)rev0;
    double rev1 = (double)pos * kRopeRev[j + 1]; rev1 -= floor(rev1); const float f1 = (float)rev1;
    const float c0 = __builtin_amdgcn_cosf(f0), s0 = __builtin_amdgcn_sinf(f0), c1 = __builtin_amdgcn_cosf(f1), s1 = __builtin_amdgcn_sinf(f1);
    w1 = pk2((a0 * c0 - b0 * s0) * scale, (a1 * c1 - b1 * s1) * scale);
    w2 = pk2((a0 * s0 + b0 * c0) * scale, (a1 * s1 + b1 * c1) * scale);
}
__device__ __forceinline__ void head96_norm_rope(v4u (&pc)[12], const float* gain, int pos, float scale) {
    float ss = 0.f;
#pragma unroll
    for (int i = 0; i < 12; ++i) ss += sumsq8(pc[i]);
    const float r = 1.0f / sqrtf(ss * (1.f / 96.f) + EPS);
    const float rs = r * scale;
#pragma unroll
    for (int i = 0; i < 8; ++i) { pc[i] = scale_piece(pc[i], rs, gain + 8 * i); asm volatile("" ::: "memory"); }
#pragma unroll
    for (int h2 = 0; h2 < 2; ++h2) {
        { unsigned w1_ = pc[8 + h2].x, w2_ = pc[10 + h2].x; rope_pair(w1_, w2_, r, scale, gain + 64 + 8 * h2 + 0, gain + 80 + 8 * h2 + 0, pos, 8 * h2 + 0); pc[8 + h2].x = w1_; pc[10 + h2].x = w2_; }
        { unsigned w1_ = pc[8 + h2].y, w2_ = pc[10 + h2].y; rope_pair(w1_, w2_, r, scale, gain + 64 + 8 * h2 + 2, gain + 80 + 8 * h2 + 2, pos, 8 * h2 + 2); pc[8 + h2].y = w1_; pc[10 + h2].y = w2_; }
        { unsigned w1_ = pc[8 + h2].z, w2_ = pc[10 + h2].z; rope_pair(w1_, w2_, r, scale, gain + 64 + 8 * h2 + 4, gain + 80 + 8 * h2 + 4, pos, 8 * h2 + 4); pc[8 + h2].z = w1_; pc[10 + h2].z = w2_; }
        { unsigned w1_ = pc[8 + h2].w, w2_ = pc[10 + h2].w; rope_pair(w1_, w2_, r, scale, gain + 64 + 8 * h2 + 6, gain + 80 + 8 * h2 + 6, pos, 8 * h2 + 6); pc[8 + h2].w = w1_; pc[10 + h2].w = w2_; }
        asm volatile("" ::: "memory");
    }
}

typedef unsigned gu32_plain;
#define XB_TMO      128
#define XB_XCNT(j)  (256  + 64 * (j))
#define XB_XSUB(j)  (1280 + 64 * (j))
#define XB_XGEN(j)  (2304 + 64 * (j))
#define XB_TOP      3328
#define XB_TOPGEN   3392
#define XCD_BAR_WORDS 3456
#define XB_SPIN_CAP (1u << 24)

__device__ __forceinline__ unsigned xb_ld(unsigned* p)              { return __hip_atomic_load(p, __ATOMIC_RELAXED, __HIP_MEMORY_SCOPE_AGENT); }
__device__ __forceinline__ unsigned xb_add(unsigned* p, unsigned v) { return __hip_atomic_fetch_add(p, v, __ATOMIC_RELAXED, __HIP_MEMORY_SCOPE_AGENT); }
__device__ __forceinline__ unsigned xb_xcc_id() { return (unsigned)__builtin_amdgcn_s_getreg((3 << 11) | 20) & 0xFu; }
#define XB_SPIN(cond, bar) do { unsigned _sp = 0; while (cond) { __builtin_amdgcn_s_sleep(1); \
    if ((++_sp & 255u) == 0u) { if (xb_ld(&(bar)[XB_TMO])) break; if (_sp > XB_SPIN_CAP) { atomicAdd(&(bar)[XB_TMO], 1u); break; } } } } while (0)

struct XcdBarrier {
    unsigned* bar; unsigned x;
    volatile LAS unsigned* st;
};

__device__ __forceinline__ XcdBarrier xcd_barrier_post(unsigned* bar, volatile LAS unsigned* st) {
    XcdBarrier b; b.bar = bar; b.x = xb_xcc_id(); b.st = st;
    if (threadIdx.x == 0) (void)xb_add(&bar[XB_XCNT(b.x)], 1u);
    return b;
}
__device__ __forceinline__ void xcd_barrier_complete(unsigned* bar, unsigned x, unsigned& nloc, unsigned& nx) {
    const unsigned G = gridDim.x * gridDim.y * gridDim.z;
    unsigned sum, cnt, mine, sp = 0u;
    for (;;) {
        sum = 0u; cnt = 0u; mine = 0u;
#pragma unroll
        for (unsigned j = 0; j < 16; ++j) { const unsigned c = xb_ld(&bar[XB_XCNT(j)]); sum += c; cnt += (c > 0u) ? 1u : 0u; mine = (j == x) ? c : mine; }
        if (sum == G) break;
        __builtin_amdgcn_s_sleep(1);
        if ((++sp & 255u) == 0u) { if (xb_ld(&bar[XB_TMO])) break; if (sp > XB_SPIN_CAP) { atomicAdd(&bar[XB_TMO], 1u); break; } }
    }
    nloc = mine > 0u ? mine : 1u; nx = cnt > 0u ? cnt : 1u;
}

__device__ __forceinline__ void xcd_barrier(const XcdBarrier& b) {
    asm volatile("s_waitcnt vmcnt(0)" ::: "memory");
    __syncthreads();
    if (threadIdx.x == 0) {
        unsigned* bar = b.bar;
        __builtin_amdgcn_s_waitcnt(0);
        unsigned nloc = b.st[0], nx = b.st[1];
        if (nloc == 0u) { xcd_barrier_complete(bar, b.x, nloc, nx); b.st[0] = nloc; b.st[1] = nx; }
        const unsigned old = xb_add(&bar[XB_XSUB(b.x)], 1u);
        const unsigned gen = old / nloc;
        if (old + 1u == (gen + 1u) * nloc) {
            __builtin_amdgcn_fence(__ATOMIC_RELEASE, "agent");
            asm volatile("s_waitcnt vmcnt(0)" ::: "memory");
            const unsigned og = xb_add(&bar[XB_TOP], 1u);
            const unsigned tg = og / nx;
            if (og + 1u == (tg + 1u) * nx) xb_add(&bar[XB_TOPGEN], 1u);
            else XB_SPIN(xb_ld(&bar[XB_TOPGEN]) == tg, bar);
            __builtin_amdgcn_fence(__ATOMIC_ACQUIRE, "agent");
            xb_add(&bar[XB_XGEN(b.x)], 1u);
            asm volatile("s_waitcnt vmcnt(0)" ::: "memory");
        } else {
            XB_SPIN(xb_ld(&bar[XB_XGEN(b.x)]) == gen, bar);
            __builtin_amdgcn_fence(__ATOMIC_ACQUIRE, "agent");
            asm volatile("s_waitcnt vmcnt(0)" ::: "memory");
        }
    }
    __syncthreads();
}

constexpr int VT_PITCH = 144;
template <int DK>
__device__ __forceinline__ void attn_unit(LAS unsigned char* lds, const bf16* __restrict__ Q, int q_ld, const bf16* __restrict__ K, int k_ld,
                                          const bf16* __restrict__ VT, int vt_ld, int nkeys, bf16* __restrict__ O, int o_ld) {
    constexpr int NCH = DK / 8, NDS = DK / 16, KBYTES = NCH * 1024, VBYTES = 64 * VT_PITCH, BUFB = KBYTES + VBYTES;
    int tid_l = threadIdx.x; asm volatile("" : "+v"(tid_l));
    const int tid = tid_l, lane = tid & 63, wid = tid >> 6, q = lane & 31, hi = lane >> 5;
    const int NT = nkeys / 64;
#if SLOW_ATTN
    LAS float* Ks = (LAS float*)lds;
    LAS float* Vs = Ks + 64 * (DK + 1);
    constexpr int DS = DK / 8;
    const int sub = tid & 7, qi = tid >> 3;
    for (int pass = 0; pass < 4; ++pass) {
        const int row = pass * 64 + qi;
        float qv[DS], o[8], m = -1e30f, l = 0.f;
#pragma unroll
        for (int i = 0; i < DS; ++i) { const unsigned short w = Q[(size_t)row * q_ld + sub * DS + i]; qv[i] = __builtin_bit_cast(float, (unsigned)w << 16); }
#pragma unroll
        for (int i = 0; i < 8; ++i) o[i] = 0.f;
        for (int t = 0; t < NT; ++t) {
            __syncthreads();
            for (int idx = tid; idx < 64 * DK; idx += NTHR) { const int key = idx / DK, d = idx % DK; Ks[key * (DK + 1) + d] = __builtin_bit_cast(float, (unsigned)K[(size_t)(t * 64 + key) * k_ld + d] << 16); }
            for (int idx = tid; idx < 64 * 64; idx += NTHR) { const int d = idx >> 6, key = idx & 63; Vs[d * 65 + key] = __builtin_bit_cast(float, (unsigned)VT[(size_t)d * vt_ld + t * 64 + key] << 16); }
            __syncthreads();
            for (int key = 0; key < 64; ++key) {
                float part = 0.f;
#pragma unroll
                for (int i = 0; i < DS; ++i) part += qv[i] * Ks[key * (DK + 1) + sub * DS + i];
                part += __shfl_xor(part, 1); part += __shfl_xor(part, 2); part += __shfl_xor(part, 4);
                const float mn = fmaxf(m, part), al = exp2f(m - mn), p = exp2f(part - mn);
                l = l * al + p; m = mn;
#pragma unroll
                for (int i = 0; i < 8; ++i) o[i] = o[i] * al + p * Vs[(8 * sub + i) * 65 + key];
            }
        }
        const float inv = 1.0f / l;
        v4u w; w.x = pk2(o[0] * inv, o[1] * inv); w.y = pk2(o[2] * inv, o[3] * inv); w.z = pk2(o[4] * inv, o[5] * inv); w.w = pk2(o[6] * inv, o[7] * inv);
        *(v4u*)(O + (size_t)row * o_ld + 8 * sub) = w;
    }
    __syncthreads();
#else
    bf16x8 qf[NDS];
    { const bf16* qp = Q + (size_t)(32 * wid + q) * q_ld + 8 * hi;
#pragma unroll
      for (int ds = 0; ds < NDS; ++ds) qf[ds] = *(const bf16x8*)(qp + 16 * ds); }
    constexpr int KP = NCH * 64;
    const int k0key = tid / NCH, k0c = tid % NCH;
    const int k1idx = tid + NTHR, k1key = k1idx / NCH, k1c = k1idx % NCH;
    const bool has_k1 = (k1idx < KP);
    const int vd = tid >> 3, vpc = tid & 7;
    const bf16* kg0 = K + (size_t)k0key * k_ld + k0c * 8;
    const bf16* kg1 = K + (size_t)(has_k1 ? k1key : 0) * k_ld + (has_k1 ? k1c : 0) * 8;
    const bf16* vg = VT + (size_t)vd * vt_ld + vpc * 8;
    const int kl0 = k0c * 1024 + (k0key ^ k0c) * 16, kl1 = k1c * 1024 + (k1key ^ k1c) * 16, vl = KBYTES + vd * VT_PITCH + (vpc >> 1) * 32 + (vpc & 1) * 8;
    v4u rk0, rv;
    rk0 = *(const v4u*)kg0; rv = *(const v4u*)vg;
    __syncthreads();
    *(LAS v4u*)(lds + kl0) = rk0; if (has_k1) { const v4u t1_ = *(const v4u*)kg1; *(LAS v4u*)(lds + kl1) = t1_; } *(LAS v2u*)(lds + vl) = (v2u){rv.x, rv.y}; *(LAS v2u*)(lds + vl + 16) = (v2u){rv.z, rv.w};
    __syncthreads();
    f32x16 o0 = {}, o1 = {};
    float mrun = -1e30f, lrun = 0.f;
    if (__builtin_amdgcn_readfirstlane(tid) >= 256) __builtin_amdgcn_s_setprio(1);
#pragma unroll 1
    for (int t = 0; t < NT; ++t) {
        LAS unsigned char* buf = lds + (t & 1) * BUFB;
        LAS unsigned char* nbuf = lds + ((t + 1) & 1) * BUFB;
        const bool pre = (t + 1 < NT);
        if (pre) { const size_t ko = (size_t)(t + 1) * 64 * k_ld; rk0 = *(const v4u*)(kg0 + ko); rv = *(const v4u*)(vg + (size_t)(t + 1) * 64); }
        f32x16 s0 = {}, s1 = {};
#pragma unroll
        for (int ds = 0; ds < NDS; ++ds) {
            const bf16x8 a0 = *(const LAS bf16x8*)(buf + (2 * ds + hi) * 1024 + (q ^ (2 * ds + hi)) * 16);
            const bf16x8 a1 = *(const LAS bf16x8*)(buf + (2 * ds + hi) * 1024 + ((32 + q) ^ (2 * ds + hi)) * 16);
            s0 = __builtin_amdgcn_mfma_f32_32x32x16_bf16(a0, qf[ds], s0, 0, 0, 0);
            s1 = __builtin_amdgcn_mfma_f32_32x32x16_bf16(a1, qf[ds], s1, 0, 0, 0);
        }
        float mx = s0[0];
#pragma unroll
        for (int r = 0; r < 16; ++r) { mx = fmaxf(mx, s0[r]); mx = fmaxf(mx, s1[r]); }
        mx = fmaxf(mx, __shfl_xor(mx, 32));
        if (__any(mx > mrun + 8.0f)) {
            const float mn = fmaxf(mrun, mx), al = __builtin_amdgcn_exp2f(mrun - mn);
            mrun = mn; lrun *= al;
#pragma unroll
            for (int r = 0; r < 16; ++r) { o0[r] *= al; o1[r] *= al; }
        }
        float ps = 0.f;
#pragma unroll
        for (int r = 0; r < 16; ++r) { s0[r] = __builtin_amdgcn_exp2f(s0[r] - mrun); s1[r] = __builtin_amdgcn_exp2f(s1[r] - mrun); ps += s0[r] + s1[r]; }
        lrun += ps;
        bf16x8 pk[2][2];
#pragma unroll
        for (int j = 0; j < 2; ++j) {
            v4u w0, w1;
            w0.x = pk2(s0[8 * j + 0], s0[8 * j + 1]); w0.y = pk2(s0[8 * j + 2], s0[8 * j + 3]); w0.z = pk2(s0[8 * j + 4], s0[8 * j + 5]); w0.w = pk2(s0[8 * j + 6], s0[8 * j + 7]);
            w1.x = pk2(s1[8 * j + 0], s1[8 * j + 1]); w1.y = pk2(s1[8 * j + 2], s1[8 * j + 3]); w1.z = pk2(s1[8 * j + 4], s1[8 * j + 5]); w1.w = pk2(s1[8 * j + 6], s1[8 * j + 7]);
            pk[0][j] = __builtin_bit_cast(bf16x8, w0); pk[1][j] = __builtin_bit_cast(bf16x8, w1);
        }
#pragma unroll
        for (int kb = 0; kb < 2; ++kb)
#pragma unroll
            for (int j = 0; j < 2; ++j) {
                const int kofs = (2 * kb + j) * 32 + hi * 16;
                const v4u A0 = *(const LAS v4u*)(buf + KBYTES + q * VT_PITCH + kofs), A1 = *(const LAS v4u*)(buf + KBYTES + (32 + q) * VT_PITCH + kofs);
                o0 = __builtin_amdgcn_mfma_f32_32x32x16_bf16(__builtin_bit_cast(bf16x8, A0), pk[kb][j], o0, 0, 0, 0);
                o1 = __builtin_amdgcn_mfma_f32_32x32x16_bf16(__builtin_bit_cast(bf16x8, A1), pk[kb][j], o1, 0, 0, 0);
            }
        if (pre) { *(LAS v4u*)(nbuf + kl0) = rk0; if (has_k1) { const v4u t1_ = *(const v4u*)(kg1 + (size_t)(t + 1) * 64 * k_ld); *(LAS v4u*)(nbuf + kl1) = t1_; } *(LAS v2u*)(nbuf + vl) = (v2u){rv.x, rv.y}; *(LAS v2u*)(nbuf + vl + 16) = (v2u){rv.z, rv.w}; }
        __syncthreads();
    }
    __builtin_amdgcn_s_setprio(0);
    lrun += __shfl_xor(lrun, 32);
    const float inv = 1.0f / lrun;
    bf16* op = O + (size_t)(32 * wid + q) * o_ld + 4 * hi;
#pragma unroll
    for (int gq = 0; gq < 4; ++gq) {
        v2u w0, w1;
        w0.x = pk2(o0[4 * gq + 0] * inv, o0[4 * gq + 1] * inv); w0.y = pk2(o0[4 * gq + 2] * inv, o0[4 * gq + 3] * inv);
        w1.x = pk2(o1[4 * gq + 0] * inv, o1[4 * gq + 1] * inv); w1.y = pk2(o1[4 * gq + 2] * inv, o1[4 * gq + 3] * inv);
        *(v2u*)(op + 8 * gq) = w0; *(v2u*)(op + 32 + 8 * gq) = w1;
    }
#endif
}


#define ATT2_SOFTMAX(S0, S1, O0, O1, MR, LR, P00, P01, P10, P11) do { \
        float mx_ = S0[0]; \
        _Pragma("unroll") for (int r_ = 0; r_ < 16; ++r_) { mx_ = fmaxf(mx_, S0[r_]); mx_ = fmaxf(mx_, S1[r_]); } \
        mx_ = fmaxf(mx_, __shfl_xor(mx_, 32)); \
        if (__any(mx_ > MR + 8.0f)) {     \
            const float mn_ = fmaxf(MR, mx_), al_ = __builtin_amdgcn_exp2f(MR - mn_); \
            MR = mn_; LR *= al_; \
            _Pragma("unroll") for (int r_ = 0; r_ < 16; ++r_) { O0[r_] *= al_; O1[r_] *= al_; } } \
        float ps_ = 0.f; \
        _Pragma("unroll") for (int r_ = 0; r_ < 16; ++r_) { S0[r_] = __builtin_amdgcn_exp2f(S0[r_] - MR); S1[r_] = __builtin_amdgcn_exp2f(S1[r_] - MR); ps_ += S0[r_] + S1[r_]; } \
        LR += ps_; \
        { v4u w_; w_.x = pk2(S0[0], S0[1]); w_.y = pk2(S0[2], S0[3]); w_.z = pk2(S0[4], S0[5]); w_.w = pk2(S0[6], S0[7]); P00 = __builtin_bit_cast(bf16x8, w_); \
          w_.x = pk2(S0[8], S0[9]); w_.y = pk2(S0[10], S0[11]); w_.z = pk2(S0[12], S0[13]); w_.w = pk2(S0[14], S0[15]); P01 = __builtin_bit_cast(bf16x8, w_); \
          w_.x = pk2(S1[0], S1[1]); w_.y = pk2(S1[2], S1[3]); w_.z = pk2(S1[4], S1[5]); w_.w = pk2(S1[6], S1[7]); P10 = __builtin_bit_cast(bf16x8, w_); \
          w_.x = pk2(S1[8], S1[9]); w_.y = pk2(S1[10], S1[11]); w_.z = pk2(S1[12], S1[13]); w_.w = pk2(S1[14], S1[15]); P11 = __builtin_bit_cast(bf16x8, w_); } } while (0)
#define ATT2_SOFTMAX_FIX(S0, S1, LR, P00, P01, P10, P11) do {     \
        float ps_ = 0.f; \
        _Pragma("unroll") for (int r_ = 0; r_ < 16; ++r_) { S0[r_] = __builtin_amdgcn_exp2f(S0[r_]); S1[r_] = __builtin_amdgcn_exp2f(S1[r_]); ps_ += S0[r_] + S1[r_]; } \
        LR += ps_; \
        { v4u w_; w_.x = pk2(S0[0], S0[1]); w_.y = pk2(S0[2], S0[3]); w_.z = pk2(S0[4], S0[5]); w_.w = pk2(S0[6], S0[7]); P00 = __builtin_bit_cast(bf16x8, w_); \
          w_.x = pk2(S0[8], S0[9]); w_.y = pk2(S0[10], S0[11]); w_.z = pk2(S0[12], S0[13]); w_.w = pk2(S0[14], S0[15]); P01 = __builtin_bit_cast(bf16x8, w_); \
          w_.x = pk2(S1[0], S1[1]); w_.y = pk2(S1[2], S1[3]); w_.z = pk2(S1[4], S1[5]); w_.w = pk2(S1[6], S1[7]); P10 = __builtin_bit_cast(bf16x8, w_); \
          w_.x = pk2(S1[8], S1[9]); w_.y = pk2(S1[10], S1[11]); w_.z = pk2(S1[12], S1[13]); w_.w = pk2(S1[14], S1[15]); P11 = __builtin_bit_cast(bf16x8, w_); } } while (0)
__device__ __forceinline__ void attn_unit2(LAS unsigned char* lds, const bf16* __restrict__ Q, int q_ld, const bf16* __restrict__ K, int k_ld,
                                           const bf16* __restrict__ VT, int vt_ld, int nkeys, bf16* __restrict__ O, int o_ld) {
    constexpr int DK = 96, NCH = DK / 8, NDS = DK / 16, KCH = 1040  , KBYTES = NCH * KCH, VBYTES = 64 * VT_PITCH, BUFB = KBYTES + VBYTES;
    int tid_l = threadIdx.x; asm volatile("" : "+v"(tid_l));
    const int tid = tid_l, lane = tid & 63, wid = tid >> 6, q = lane & 31, hi = lane >> 5;
    const int NT = nkeys / 64;
    bf16x8 qfA[NDS], qfB[NDS];
    { const bf16* qp = Q + (size_t)(64 * wid + q) * q_ld + 8 * hi;
#pragma unroll
      for (int ds = 0; ds < NDS; ++ds) { qfA[ds] = *(const bf16x8*)(qp + 16 * ds); qfB[ds] = *(const bf16x8*)(qp + (size_t)32 * q_ld + 16 * ds); } }
    constexpr int KP = NCH * 64;
    const int k0key = tid / NCH, k0c = tid % NCH;
    const int k1idx = tid + NTHR, k1key = k1idx / NCH, k1c = k1idx % NCH;
    const bool has_k1 = (k1idx < KP);
    const int vd = tid >> 3, vpc = tid & 7;
    const unsigned kof0 = (unsigned)(k0key * k_ld + k0c * 8) * 2u, kof1 = (unsigned)((has_k1 ? k1key : 0) * k_ld + (has_k1 ? k1c : 0) * 8) * 2u, vof = (unsigned)(vd * vt_ld + vpc * 8) * 2u;
    const int kl0 = k0c * KCH + k0key * 16, kl1 = k1c * KCH + k1key * 16, vl = KBYTES + vd * VT_PITCH + (vpc >> 1) * 32 + (vpc & 1) * 8;
    v4u rk0, rk1, rv;
    rk0 = *(const v4u*)((const char*)K + kof0); if (has_k1) rk1 = *(const v4u*)((const char*)K + kof1); rv = *(const v4u*)((const char*)VT + vof);
    __syncthreads();
    *(LAS v4u*)(lds + kl0) = rk0; if (has_k1) *(LAS v4u*)(lds + kl1) = rk1; *(LAS v2u*)(lds + vl) = (v2u){rv.x, rv.y}; *(LAS v2u*)(lds + vl + 16) = (v2u){rv.z, rv.w};
    __syncthreads();
    f32x16 oA0 = {}, oA1 = {}, oB0 = {}, oB1 = {};
    float lA = 0.f, lB = 0.f;
    if (__builtin_amdgcn_readfirstlane(tid) >= 256) __builtin_amdgcn_s_setprio(1);
#pragma unroll 1
    for (int t = 0; t < NT; ++t) {
        LAS unsigned char* buf = lds + (t & 1) * BUFB;
        LAS unsigned char* nbuf = lds + ((t + 1) & 1) * BUFB;
        const bool pre = (t + 1 < NT);
        if (pre) { const char* kt_ = (const char*)K + (size_t)(t + 1) * 64 * k_ld * 2; const char* vt_ = (const char*)VT + (size_t)(t + 1) * 128; rk0 = *(const v4u*)(kt_ + kof0); if (has_k1) rk1 = *(const v4u*)(kt_ + kof1); rv = *(const v4u*)(vt_ + vof); }
        f32x16 sA0 = {}, sA1 = {}, sB0 = {}, sB1 = {};
#pragma unroll
        for (int ds = 0; ds < NDS; ++ds) {
            const bf16x8 a0 = *(const LAS bf16x8*)(buf + hi * KCH + q * 16 + ds * (2 * KCH));
            const bf16x8 a1 = *(const LAS bf16x8*)(buf + hi * KCH + q * 16 + ds * (2 * KCH) + 512);
            sA0 = __builtin_amdgcn_mfma_f32_32x32x16_bf16(a0, qfA[ds], sA0, 0, 0, 0);
            sA1 = __builtin_amdgcn_mfma_f32_32x32x16_bf16(a1, qfA[ds], sA1, 0, 0, 0);
            sB0 = __builtin_amdgcn_mfma_f32_32x32x16_bf16(a0, qfB[ds], sB0, 0, 0, 0);
            sB1 = __builtin_amdgcn_mfma_f32_32x32x16_bf16(a1, qfB[ds], sB1, 0, 0, 0);
        }
        bf16x8 pA00, pA01, pA10, pA11, pB00, pB01, pB10, pB11;
        ATT2_SOFTMAX_FIX(sA0, sA1, lA, pA00, pA01, pA10, pA11); ATT2_SOFTMAX_FIX(sB0, sB1, lB, pB00, pB01, pB10, pB11);
#pragma unroll
        for (int kb = 0; kb < 2; ++kb)
#pragma unroll
            for (int j = 0; j < 2; ++j) {
                const int kofs = (2 * kb + j) * 32 + hi * 16;
                const v4u A0 = *(const LAS v4u*)(buf + KBYTES + q * VT_PITCH + kofs), A1 = *(const LAS v4u*)(buf + KBYTES + (32 + q) * VT_PITCH + kofs);
                const bf16x8 pa = kb == 0 ? (j == 0 ? pA00 : pA01) : (j == 0 ? pA10 : pA11), pb = kb == 0 ? (j == 0 ? pB00 : pB01) : (j == 0 ? pB10 : pB11);
                oA0 = __builtin_amdgcn_mfma_f32_32x32x16_bf16(__builtin_bit_cast(bf16x8, A0), pa, oA0, 0, 0, 0);
                oA1 = __builtin_amdgcn_mfma_f32_32x32x16_bf16(__builtin_bit_cast(bf16x8, A1), pa, oA1, 0, 0, 0);
                oB0 = __builtin_amdgcn_mfma_f32_32x32x16_bf16(__builtin_bit_cast(bf16x8, A0), pb, oB0, 0, 0, 0);
                oB1 = __builtin_amdgcn_mfma_f32_32x32x16_bf16(__builtin_bit_cast(bf16x8, A1), pb, oB1, 0, 0, 0);
            }
        if (pre) { *(LAS v4u*)(nbuf + kl0) = rk0; if (has_k1) *(LAS v4u*)(nbuf + kl1) = rk1; *(LAS v2u*)(nbuf + vl) = (v2u){rv.x, rv.y}; *(LAS v2u*)(nbuf + vl + 16) = (v2u){rv.z, rv.w}; }
        __syncthreads();
    }
    __builtin_amdgcn_s_setprio(0);
    lA += __shfl_xor(lA, 32); lB += __shfl_xor(lB, 32);
    const float invA = 1.0f / lA, invB = 1.0f / lB;
    bf16* opA = O + (size_t)(64 * wid + q) * o_ld + 4 * hi; bf16* opB = opA + (size_t)32 * o_ld;
#pragma unroll
    for (int gq = 0; gq < 4; ++gq) {
        v2u w0, w1;
        w0.x = pk2(oA0[4 * gq + 0] * invA, oA0[4 * gq + 1] * invA); w0.y = pk2(oA0[4 * gq + 2] * invA, oA0[4 * gq + 3] * invA);
        w1.x = pk2(oA1[4 * gq + 0] * invA, oA1[4 * gq + 1] * invA); w1.y = pk2(oA1[4 * gq + 2] * invA, oA1[4 * gq + 3] * invA);
        *(v2u*)(opA + 8 * gq) = w0; *(v2u*)(opA + 32 + 8 * gq) = w1;
        w0.x = pk2(oB0[4 * gq + 0] * invB, oB0[4 * gq + 1] * invB); w0.y = pk2(oB0[4 * gq + 2] * invB, oB0[4 * gq + 3] * invB);
        w1.x = pk2(oB1[4 * gq + 0] * invB, oB1[4 * gq + 1] * invB); w1.y = pk2(oB1[4 * gq + 2] * invB, oB1[4 * gq + 3] * invB);
        *(v2u*)(opB + 8 * gq) = w0; *(v2u*)(opB + 32 + 8 * gq) = w1;
    }
}


__device__ __forceinline__ void attn_unit3(LAS unsigned char* lds, const bf16* __restrict__ Q, int q_ld, const bf16* __restrict__ K, int k_ld,
                                           const bf16* __restrict__ VT, int vt_ld, int nkeys, bf16* __restrict__ O, int o_ld) {
    constexpr int DK = 96, NCH = DK / 8, NDS = DK / 16, KCH = 1040, KBYTES = NCH * KCH, VBYTES = 64 * VT_PITCH, VOFF = 2 * KBYTES;
    int tid_l = threadIdx.x; asm volatile("" : "+v"(tid_l));
    const int tid = tid_l, lane = tid & 63, wid = tid >> 6, q = lane & 31, hi = lane >> 5;
    const int NT = nkeys / 64;
    const bool grpA = (wid < 4);
    bf16x8 qfA[NDS], qfB[NDS];
    { const bf16* qp = Q + (size_t)(64 * wid + q) * q_ld + 8 * hi;
#pragma unroll
      for (int ds = 0; ds < NDS; ++ds) { qfA[ds] = *(const bf16x8*)(qp + 16 * ds); qfB[ds] = *(const bf16x8*)(qp + (size_t)32 * q_ld + 16 * ds); } }
    constexpr int KP = NCH * 64;
    const int k0key = tid / NCH, k0c = tid % NCH;
    const int k1idx = tid + NTHR, k1key = k1idx / NCH, k1c = k1idx % NCH;
    const bool has_k1 = (k1idx < KP);
    const int vd = tid >> 3, vpc = tid & 7;
    const unsigned kof0 = (unsigned)(k0key * k_ld + k0c * 8) * 2u, kof1 = (unsigned)((has_k1 ? k1key : 0) * k_ld + (has_k1 ? k1c : 0) * 8) * 2u, vof = (unsigned)(vd * vt_ld + vpc * 8) * 2u;
    const int kl0 = k0c * KCH + k0key * 16, kl1 = k1c * KCH + k1key * 16, vl = VOFF + vd * VT_PITCH + (vpc >> 1) * 32 + (vpc & 1) * 8;
    v4u rk0, rk1, rv;
#define A3_LOADK(t_) do { const char* kt_ = (const char*)K + (size_t)(t_) * 64 * k_ld * 2; rk0 = *(const v4u*)(kt_ + kof0); if (has_k1) rk1 = *(const v4u*)(kt_ + kof1); } while (0)
#define A3_LOADV(t_) do { rv = *(const v4u*)((const char*)VT + (size_t)(t_) * 128 + vof); } while (0)
#define A3_STOREK(s_) do { *(LAS v4u*)(lds + (s_) * KBYTES + kl0) = rk0; if (has_k1) *(LAS v4u*)(lds + (s_) * KBYTES + kl1) = rk1; } while (0)
#define A3_STOREV(s_) do { *(LAS v2u*)(lds + (s_) * VBYTES + vl) = (v2u){rv.x, rv.y}; *(LAS v2u*)(lds + (s_) * VBYTES + vl + 16) = (v2u){rv.z, rv.w}; } while (0)
#define A3_BAR() asm volatile("s_waitcnt lgkmcnt(0)\n\ts_barrier" ::: "memory")
    f32x16 oA0 = {}, oA1 = {}, oB0 = {}, oB1 = {}, sA0 = {}, sA1 = {}, sB0 = {}, sB1 = {};
#define A3_PKGET(S_, i_) __builtin_bit_cast(bf16x8, (f32x4){S_[4 * (i_)], S_[4 * (i_) + 1], S_[4 * (i_) + 2], S_[4 * (i_) + 3]})
#define A3_PKSET(S_, i_, P_) do { const f32x4 w4_ = __builtin_bit_cast(f32x4, P_); S_[4 * (i_)] = w4_[0]; S_[4 * (i_) + 1] = w4_[1]; S_[4 * (i_) + 2] = w4_[2]; S_[4 * (i_) + 3] = w4_[3]; } while (0)
    float lA = 0.f, lB = 0.f;
#define A3_X(tx_) do { const int tx = (tx_); \
        if (tx >= 1) { LAS unsigned char* vb_ = lds + ((tx - 1) & 1) * VBYTES + VOFF; \
            _Pragma("unroll") for (int kj = 0; kj < 4; ++kj) { \
                const int kofs = kj * 32 + hi * 16; \
                const v4u A0 = *(const LAS v4u*)(vb_ + q * VT_PITCH + kofs), A1 = *(const LAS v4u*)(vb_ + (32 + q) * VT_PITCH + kofs); \
                const bf16x8 pa = A3_PKGET(sA0, kj), pb = A3_PKGET(sB0, kj); \
                oA0 = __builtin_amdgcn_mfma_f32_32x32x16_bf16(__builtin_bit_cast(bf16x8, A0), pa, oA0, 0, 0, 0); \
                oA1 = __builtin_amdgcn_mfma_f32_32x32x16_bf16(__builtin_bit_cast(bf16x8, A1), pa, oA1, 0, 0, 0); \
                oB0 = __builtin_amdgcn_mfma_f32_32x32x16_bf16(__builtin_bit_cast(bf16x8, A0), pb, oB0, 0, 0, 0); \
                oB1 = __builtin_amdgcn_mfma_f32_32x32x16_bf16(__builtin_bit_cast(bf16x8, A1), pb, oB1, 0, 0, 0); } } \
        if (tx < NT) { LAS unsigned char* kb_ = lds + (tx & 1) * KBYTES; \
            _Pragma("unroll") for (int r_ = 0; r_ < 16; ++r_) { sA0[r_] = 0.f; sA1[r_] = 0.f; sB0[r_] = 0.f; sB1[r_] = 0.f; } \
            _Pragma("unroll") for (int ds = 0; ds < NDS; ++ds) { \
                const bf16x8 a0 = *(const LAS bf16x8*)(kb_ + hi * KCH + q * 16 + ds * (2 * KCH)); \
                const bf16x8 a1 = *(const LAS bf16x8*)(kb_ + hi * KCH + q * 16 + ds * (2 * KCH) + 512); \
                sA0 = __builtin_amdgcn_mfma_f32_32x32x16_bf16(a0, qfA[ds], sA0, 0, 0, 0); \
                sA1 = __builtin_amdgcn_mfma_f32_32x32x16_bf16(a1, qfA[ds], sA1, 0, 0, 0); \
                sB0 = __builtin_amdgcn_mfma_f32_32x32x16_bf16(a0, qfB[ds], sB0, 0, 0, 0); \
                sB1 = __builtin_amdgcn_mfma_f32_32x32x16_bf16(a1, qfB[ds], sB1, 0, 0, 0); } } } while (0)
#define A3_Y() do { bf16x8 p0_, p1_, p2_, p3_; \
        ATT2_SOFTMAX_FIX(sA0, sA1, lA, p0_, p1_, p2_, p3_); A3_PKSET(sA0, 0, p0_); A3_PKSET(sA0, 1, p1_); A3_PKSET(sA0, 2, p2_); A3_PKSET(sA0, 3, p3_); \
        ATT2_SOFTMAX_FIX(sB0, sB1, lB, p0_, p1_, p2_, p3_); A3_PKSET(sB0, 0, p0_); A3_PKSET(sB0, 1, p1_); A3_PKSET(sB0, 2, p2_); A3_PKSET(sB0, 3, p3_); } while (0)
    A3_LOADK(0);
    __syncthreads();
    A3_STOREK(0);
    A3_LOADK(1);
    A3_BAR();
#pragma unroll 1
    for (int t = 0; t <= NT; ++t) {
        if (t < NT) A3_LOADV(t);
        if (grpA) A3_X(t); else if (t >= 1) A3_Y();
        if (t + 1 < NT) A3_STOREK((t + 1) & 1);
        A3_BAR();
        if (t + 2 < NT) A3_LOADK(t + 2);
        if (grpA) { if (t < NT) A3_Y(); } else A3_X(t);
        if (t < NT) A3_STOREV(t & 1);
        A3_BAR();
    }
#undef A3_LOADK
#undef A3_LOADV
#undef A3_STOREK
#undef A3_STOREV
#undef A3_BAR
#undef A3_X
#undef A3_PKGET
#undef A3_PKSET
#undef A3_Y
    lA += __shfl_xor(lA, 32); lB += __shfl_xor(lB, 32);
    const float invA = 1.0f / lA, invB = 1.0f / lB;
    int tid_e = threadIdx.x; asm volatile("" : "+v"(tid_e));
    const int wid_e = tid_e >> 6, q_e = tid_e & 31, hi_e = (tid_e >> 5) & 1;
    bf16* opA = O + (size_t)(64 * wid_e + q_e) * o_ld + 4 * hi_e; bf16* opB = opA + (size_t)32 * o_ld;
#pragma unroll
    for (int gq = 0; gq < 4; ++gq) {
        v2u w0, w1;
        w0.x = pk2(oA0[4 * gq + 0] * invA, oA0[4 * gq + 1] * invA); w0.y = pk2(oA0[4 * gq + 2] * invA, oA0[4 * gq + 3] * invA);
        w1.x = pk2(oA1[4 * gq + 0] * invA, oA1[4 * gq + 1] * invA); w1.y = pk2(oA1[4 * gq + 2] * invA, oA1[4 * gq + 3] * invA);
        *(v2u*)(opA + 8 * gq) = w0; *(v2u*)(opA + 32 + 8 * gq) = w1;
        w0.x = pk2(oB0[4 * gq + 0] * invB, oB0[4 * gq + 1] * invB); w0.y = pk2(oB0[4 * gq + 2] * invB, oB0[4 * gq + 3] * invB);
        w1.x = pk2(oB1[4 * gq + 0] * invB, oB1[4 * gq + 1] * invB); w1.y = pk2(oB1[4 * gq + 2] * invB, oB1[4 * gq + 3] * invB);
        *(v2u*)(opB + 8 * gq) = w0; *(v2u*)(opB + 32 + 8 * gq) = w1;
    }
    __syncthreads();
}

#define DECL_PTRS \
    int tid_p = threadIdx.x; asm volatile("" : "+v"(tid_p));     \
    const int tid = tid_p, lane = tid & 63, wave = __builtin_amdgcn_readfirstlane(tid >> 6); \
    const int gw = vcu * NWAVES + wave, gt = bx * NTHR + tid; (void)gw; (void)gt; (void)lane; \
    size_t zoff_ = 0; asm volatile("" : "+s"(zoff_));     \
    unsigned char* ws = a.ws + zoff_; unsigned char* dob = (unsigned char*)a.out + zoff_; \
    const float* xp = a.in[0]; const float* xs = a.in[1]; const float* memp = a.in[2]; const float* mems = a.in[3]; \
    bf16* WinT = (bf16*)(ws + WS_WIN); bf16* WuqT = (bf16*)(ws + WS_WUQ); bf16* WukvT = (bf16*)(ws + WS_WUKV); bf16* WgluT = (bf16*)(ws + WS_WGLU); \
    bf16* WmkvT = (bf16*)(ws + WS_WMKV); bf16* WbT = (bf16*)(ws + WS_WB); \
    bf16* WoutT = (bf16*)(ws + WS_WOUT); bf16* WguT = (bf16*)(ws + WS_WGU); bf16* WdT = (bf16*)(ws + WS_WD); \
    bf16* BtY = (bf16*)(ws + WS_BTY); bf16* Bst = (bf16*)(ws + WS_BST); float* Klag = (float*)(ws + WS_KLAG); \
    float* RQ = (float*)(ws + WS_RQ); float* RKV = (float*)(ws + WS_RKV); bf16* MK = (bf16*)(ws + WS_MK); bf16* MVT = (bf16*)(ws + WS_MVT); \
    bf16* MQ = (bf16*)(ws + WS_MQ); bf16* Ure = (bf16*)(ws + WS_URE); float* Sst = (float*)(ws + WS_SST); bf16* Merged = (bf16*)(ws + WS_MERGED); \
    bf16* Zs = (bf16*)(ws + WS_ZS); bf16* OB = (bf16*)(ws + WS_OB); bf16* Yact = (bf16*)(ws + WS_YACT); \
    bf16* H2 = (bf16*)(ws + WS_H2); bf16* Gt = (bf16*)(ws + WS_G); bf16* Act = (bf16*)(ws + WS_ACT); \
    bf16* XN = (bf16*)(dob + DO_XN); bf16* MEMN = (bf16*)(dob + DO_MEMN); bf16* Qf = (bf16*)(dob + DO_QF); bf16* Kf = (bf16*)(dob + DO_KF); bf16* VTb = (bf16*)(dob + DO_VT); \
    const float* lam_re = a.in[13]; const float* lam_im = a.in[14]; const float* logstep = a.in[15]; \
    const float* b_re = a.in[16]; const float* b_im = a.in[17]; const float* c_re = a.in[18]; const float* c_im = a.in[19];

struct Args { const float* in[33]; float* out; unsigned char* ws; };

__global__ void __launch_bounds__(NTHR, 2) fwd_megakernel(Args a) {
    extern __shared__ __attribute__((aligned(16))) unsigned char lds_raw[];
    LAS unsigned char* lds = (LAS unsigned char*)lds_raw;
    cg::grid_group grid = cg::this_grid();
    const int G = gridDim.x, bx = blockIdx.x;
    const int vcu = (G % 8 == 0) ? (bx % 8) * (G / 8) + bx / 8 : bx;
    const int NGW = G * NWAVES, NGT = G * NTHR;
    volatile LAS unsigned* bst = (volatile LAS unsigned*)(lds + 131072 + 64);
    if (threadIdx.x < 2) bst[threadIdx.x] = 0u;
    __syncthreads();
    XcdBarrier xbar = xcd_barrier_post((unsigned*)(a.ws + WS_BAR), bst);
#if (PHM >> 0) & 1
    for (int rep_ = 0; rep_ < 1 + ((DUPM >> 0) & 1); ++rep_) { DECL_PTRS;
    {
        LAS float* scr = (LAS float*)(lds + wave * 16384);
#define TRANS(W, K_, N_, WT, LDW, RM, KS) for (int it = gw; it < ((K_) / 64) * ((N_) / 32); it += NGW) transpose_item((W), (K_), (N_), (WT), (LDW), RM, (KS), scr, it, lane)
        TRANS(a.in[6], 1024, 4256, WinT, 1024, RmWin(), (const float*)nullptr);
        TRANS(a.in[9], 384, 768, WuqT, 384, RmId(), a.in[7]);
        TRANS(a.in[10], 256, 1024, WukvT, 256, RmUkv(), a.in[8]);
        TRANS(a.in[21], 256, 256, WgluT, 256, RmId(), (const float*)nullptr);
        TRANS(a.in[22], 1024, 512, WmkvT, 1024, RmId(), (const float*)nullptr);
        TRANS(a.in[25], 512, 1024, WbT, 1024, RmId(), (const float*)nullptr);
        TRANS(a.in[26], 256, 1024, WbT + 512, 1024, RmId(), (const float*)nullptr);
        TRANS(a.in[27], 256, 1024, WbT + 768, 1024, RmId(), (const float*)nullptr);
        TRANS(a.in[28], 1024, 1024, WoutT, 1024, RmId(), (const float*)nullptr);
        TRANS(a.in[30], 1024, 2816, WguT, 1024, RmGate(), a.in[29]);
        TRANS(a.in[31], 1024, 2816, WguT, 1024, RmUp(), a.in[29]);
        TRANS(a.in[32], 2816, 1024, WdT, 2816, RmId(), (const float*)nullptr);
#undef TRANS
        for (int i = gt; i < MT; i += NGT) ((float*)(ws + WS_RSS))[i] = 0.f;
        for (int i = gt; i < 96 * 1024 / 8; i += NGT) *(v4u*)(WinT + (size_t)672 * 1024 + (size_t)i * 8) = (v4u){0u, 0u, 0u, 0u};
        for (int m = gw; m < MT; m += 4 * NGW) {
            if (m + 3 * NGW < MT) {
                const f32x4* xr[4]; f32x4 v[4][4]; float s[4];
#pragma unroll
                for (int u = 0; u < 4; ++u) { xr[u] = (const f32x4*)xrow_ptr(xp, xs, m + u * NGW) + lane;
#pragma unroll
                    for (int j = 0; j < 4; ++j) v[u][j] = xr[u][64 * j]; }
#pragma unroll
                for (int u = 0; u < 4; ++u) { s[u] = 0.f;
#pragma unroll
                    for (int j = 0; j < 4; ++j) s[u] += (v[u][j].x * v[u][j].x + v[u][j].y * v[u][j].y) + (v[u][j].z * v[u][j].z + v[u][j].w * v[u][j].w); }
#pragma unroll
                for (int u = 0; u < 4; ++u) { const float r = 1.0f / sqrtf(wave_sum(s[u]) * (1.f / DM) + EPS);
                    unsigned long long* o8 = (unsigned long long*)(XN + (size_t)(m + u * NGW) * DM) + lane; const f32x4* gr = (const f32x4*)a.in[4] + lane;
#pragma unroll
                    for (int j = 0; j < 4; ++j) { const f32x4 gg = gr[64 * j];
                        o8[64 * j] = (unsigned long long)pk2(v[u][j].x * r * gg.x, v[u][j].y * r * gg.y) | ((unsigned long long)pk2(v[u][j].z * r * gg.z, v[u][j].w * r * gg.w) << 32); } }
            } else { for (int u = 0; u < 4; ++u) if (m + u * NGW < MT) rms_row_to_bf16(xrow_ptr(xp, xs, m + u * NGW), a.in[4], XN + (size_t)(m + u * NGW) * DM, lane); }
        }
        for (int m = gw; m < MMEM; m += NGW) rms_row_to_bf16(m < NPROMPT * MEMTOK ? memp + (size_t)m * DM : mems + (size_t)(m - NPROMPT * MEMTOK) * DM, a.in[5], MEMN + (size_t)m * DM, lane);
        {
            LAS float* wre = (LAS float*)lds; LAS float* wim = wre + 64;
            for (int item = bx; item < 16 * 2 * 64; item += G) {
                const int k = item & 63, dir = (item >> 6) & 1, g = item >> 7, gd = dir * 16 + g;
                __syncthreads();
                if (tid < 64) { const int p = tid; const float dt = expf(logstep[gd]); const float lre = lam_re[gd * 64 + p], lim = lam_im[gd * 64 + p];
                    float zr, zi, pr, pi; zcoef(lre, lim, dt, zr, zi); cpowk(lre, lim, dt, k, pr, pi);
                    wre[p] = pr * zr - pi * zi; wim[p] = pr * zi + pi * zr; }
                __syncthreads();
                if (tid < 256) { const int hp = tid & 15, h = tid >> 4; float acc = 0.f;
                    for (int p = 0; p < 64; ++p) {
                        const float br = b_re[(gd * 64 + p) * 16 + hp], bi = b_im[(gd * 64 + p) * 16 + hp];
                        const float wr = wre[p] * br - wim[p] * bi, wi = wre[p] * bi + wim[p] * br;
                        acc += c_re[(gd * 16 + h) * 64 + p] * wr - c_im[(gd * 16 + h) * 64 + p] * wi; }
                    Klag[(size_t)item * 256 + tid] = acc; }
            }
            __syncthreads();
        }
        for (int idx = gt; idx < 16 * 2 * 64 * 64; idx += NGT) {
            const int p = idx & 63, s = (idx >> 6) & 63, dir = (idx >> 12) & 1, g = idx >> 13, gd = dir * 16 + g;
            const float dt = expf(logstep[gd]); const float lre = lam_re[gd * 64 + p], lim = lam_im[gd * 64 + p];
            float zr, zi, pr, pi; zcoef(lre, lim, dt, zr, zi); cpowk(lre, lim, dt, dir == 0 ? 63 - s : s, pr, pi);
            const float wr0 = pr * zr - pi * zi, wi0 = pr * zi + pi * zr;
            const float* brp = b_re + (gd * 64 + p) * 16; const float* bip = b_im + (gd * 64 + p) * 16;
            float vr[16], vi[16];
#pragma unroll
            for (int hp = 0; hp < 16; ++hp) { const float br = brp[hp], bi = bip[hp]; vr[hp] = wr0 * br - wi0 * bi; vi[hp] = wr0 * bi + wi0 * br; }
            bf16* dre = Bst + ((size_t)(g * 256 + dir * 128 + p)) * 1024 + s * 16; bf16* dim_ = dre + (size_t)64 * 1024;
            v4u o;
            o.x = pk2(vr[0], vr[1]); o.y = pk2(vr[2], vr[3]); o.z = pk2(vr[4], vr[5]); o.w = pk2(vr[6], vr[7]); *(v4u*)dre = o;
            o.x = pk2(vr[8], vr[9]); o.y = pk2(vr[10], vr[11]); o.z = pk2(vr[12], vr[13]); o.w = pk2(vr[14], vr[15]); *(v4u*)(dre + 8) = o;
            o.x = pk2(vi[0], vi[1]); o.y = pk2(vi[2], vi[3]); o.z = pk2(vi[4], vi[5]); o.w = pk2(vi[6], vi[7]); *(v4u*)dim_ = o;
            o.x = pk2(vi[8], vi[9]); o.y = pk2(vi[10], vi[11]); o.z = pk2(vi[12], vi[13]); o.w = pk2(vi[14], vi[15]); *(v4u*)(dim_ + 8) = o;
        }
        for (int idx = gt; idx < 16 * 2 * 64 * 64; idx += NGT) {
            const int p = idx & 63, t = (idx >> 6) & 63, dir = (idx >> 12) & 1, g = idx >> 13, gd = dir * 16 + g;
            const float dt = expf(logstep[gd]); const float lre = lam_re[gd * 64 + p], lim = lam_im[gd * 64 + p];
            float pr, pi; cpowk(lre, lim, dt, dir == 0 ? t + 1 : 64 - t, pr, pi);
            bf16* d0 = BtY + ((size_t)g * 1024 + t * 16) * ULD + 1024 + dir * 128 + p;
#pragma unroll
            for (int h = 0; h < 16; ++h) { const float cr = c_re[(gd * 16 + h) * 64 + p], ci = c_im[(gd * 16 + h) * 64 + p];
                const float wr = cr * pr - ci * pi, wi = cr * pi + ci * pr;
                d0[(size_t)h * ULD] = (bf16)f2bf(wr); d0[(size_t)h * ULD + 64] = (bf16)f2bf(-wi); }
        }
    }
    }
#endif
    if (a.ws == nullptr) grid.sync();
    xcd_barrier(xbar);

#if EXTRA_SYNCS
    for (int es_ = 0; es_ < EXTRA_SYNCS; ++es_) grid.sync();
#endif
#if (PHM >> 1) & 1
    for (int rep_ = 0; rep_ < 1 + ((DUPM >> 1) & 1); ++rep_) { DECL_PTRS;
    {
        { pg8::Gemm g{XN, WinT, MT, NZ, 1024, 1024, 1024}; pg8::StaticOrder S; S.init(MT, NZ, G, bx); EpiZ E{Zs, Gt}; run_gemm(lds, g, S, E); }
        { pg8::Gemm g{MEMN, WmkvT, MMEM, 256, 1024, 1024, 1024}; pg8::StaticOrder S; S.init(MMEM, 256, G, (bx + G - 64) % G);       EpiStore E{MK, 256}; run_gemm(lds, g, S, E); }
        { pg8::Gemm g{WmkvT + (size_t)256 * 1024, MEMN, 256, MMEM, 1024, 1024, 1024}; pg8::StaticOrder S; S.init(256, MMEM, G, (bx + G - 128) % G); EpiStore E{MVT, MMEM}; run_gemm(lds, g, S, E); }
        for (int idx = gt; idx < 16 * 1024 * 128; idx += NGT) {
            const int k8 = idx & 127, n = (idx >> 7) & 1023, g = idx >> 17;
            const int t = n >> 4, h = n & 15, s = k8 >> 1, hp0 = (k8 & 1) * 8;
            float v[8];
#pragma unroll
            for (int i = 0; i < 8; ++i) v[i] = 0.f;
            if (t >= s) { const float* kp = Klag + ((size_t)((g * 2 + 0) * 64 + (t - s)) * 256 + h * 16 + hp0);
#pragma unroll
                for (int i = 0; i < 8; ++i) v[i] += kp[i]; }
            if (s >= t) { const float* kp = Klag + ((size_t)((g * 2 + 1) * 64 + (s - t)) * 256 + h * 16 + hp0);
#pragma unroll
                for (int i = 0; i < 8; ++i) v[i] += kp[i]; }
            v4u o; o.x = pk2(v[0], v[1]); o.y = pk2(v[2], v[3]); o.z = pk2(v[4], v[5]); o.w = pk2(v[6], v[7]);
            *(v4u*)(BtY + ((size_t)g * 1024 + n) * ULD + k8 * 8) = o;
        }
    }
    }
#endif
    xcd_barrier(xbar);

#if (PHM >> 2) & 1
    for (int rep_ = 0; rep_ < 1 + ((DUPM >> 2) & 1); ++rep_) { DECL_PTRS;
    {
        const float* gmq = a.in[23]; const float* gmk = a.in[24];
        for (int m0 = gw; m0 < MT; m0 += 4 * NGW) {
            v4u q0[4], q1[4], q2[4];
#pragma unroll
            for (int u = 0; u < 4; ++u) { const int mu = m0 + u * NGW; q0[u] = q1[u] = q2[u] = (v4u){0u, 0u, 0u, 0u};
                if (mu < MT) { const v4u* zr = (const v4u*)(Zs + (size_t)mu * NZS); q0[u] = zr[lane]; q1[u] = zr[64 + lane]; if (lane < 32) q2[u] = zr[128 + lane]; } }
#pragma unroll
            for (int u = 0; u < 4; ++u) { const int m = m0 + u * NGW; if (m >= MT) break;
            const v4u p0 = q0[u], p1 = q1[u], p2 = q2[u];
            const float sq0 = sumsq8(p0), sq1 = sumsq8(p1), sq2 = sumsq8(p2);
            float sa = lane < 48 ? sq0 : 0.f, sb = (lane >= 48 ? sq0 : 0.f) + (lane < 16 ? sq1 : 0.f);
            sa = wave_sum(sa); sb = wave_sum(sb);
            { const float rq = 1.0f / sqrtf(sa * (1.f / 384.f) + EPS), rkv = 1.0f / sqrtf(sb * (1.f / 256.f) + EPS);
              const float r0 = lane < 48 ? rq : rkv; v4u o;
              o.x = pk2(bflo(p0.x) * r0, bfhi(p0.x) * r0); o.y = pk2(bflo(p0.y) * r0, bfhi(p0.y) * r0); o.z = pk2(bflo(p0.z) * r0, bfhi(p0.z) * r0); o.w = pk2(bflo(p0.w) * r0, bfhi(p0.w) * r0);
              ((v4u*)(Zs + (size_t)m * NZS))[lane] = o;
              if (lane < 16) { o.x = pk2(bflo(p1.x) * rkv, bfhi(p1.x) * rkv); o.y = pk2(bflo(p1.y) * rkv, bfhi(p1.y) * rkv); o.z = pk2(bflo(p1.z) * rkv, bfhi(p1.z) * rkv); o.w = pk2(bflo(p1.w) * rkv, bfhi(p1.w) * rkv);
                  ((v4u*)(Zs + (size_t)m * NZS))[64 + lane] = o; } }
            if (lane >= 32) { const int j = lane - 32; *(v4u*)(Ure + ((size_t)((j >> 1) * SROWS + (m >> 6)) * ULD + (m & 63) * 16 + (j & 1) * 8)) = p1; }
            float hq = sq2; hq += __shfl_xor(hq, 1); hq += __shfl_xor(hq, 2); hq += __shfl_xor(hq, 4);
            if (lane < 32) { const float r = MQSCALE / sqrtf(hq * (1.f / 64.f) + EPS); const float* gg = gmq + (lane & 7) * 8; v4u o;
                o.x = pk2(bflo(p2.x) * r * gg[0], bfhi(p2.x) * r * gg[1]); o.y = pk2(bflo(p2.y) * r * gg[2], bfhi(p2.y) * r * gg[3]);
                o.z = pk2(bflo(p2.z) * r * gg[4], bfhi(p2.z) * r * gg[5]); o.w = pk2(bflo(p2.w) * r * gg[6], bfhi(p2.w) * r * gg[7]);
                *(v4u*)(MQ + (size_t)m * 256 + lane * 8) = o; }
            }
        }
        for (int m = gw; m < MMEM; m += NGW) {
            v4u p2 = (v4u){0u, 0u, 0u, 0u}; if (lane < 32) p2 = *(const v4u*)(MK + (size_t)m * 256 + lane * 8);
            float hq = sumsq8(p2); hq += __shfl_xor(hq, 1); hq += __shfl_xor(hq, 2); hq += __shfl_xor(hq, 4);
            if (lane < 32) { const float r = 1.0f / sqrtf(hq * (1.f / 64.f) + EPS); const float* gg = gmk + (lane & 7) * 8; v4u o;
                o.x = pk2(bflo(p2.x) * r * gg[0], bfhi(p2.x) * r * gg[1]); o.y = pk2(bflo(p2.y) * r * gg[2], bfhi(p2.y) * r * gg[3]);
                o.z = pk2(bflo(p2.z) * r * gg[4], bfhi(p2.z) * r * gg[5]); o.w = pk2(bflo(p2.w) * r * gg[6], bfhi(p2.w) * r * gg[7]);
                *(v4u*)(MK + (size_t)m * 256 + lane * 8) = o; }
        }
    }
    }
#endif
    xcd_barrier(xbar);

#if (PHM >> 3) & 1
    for (int rep_ = 0; rep_ < 1 + ((DUPM >> 3) & 1); ++rep_) { DECL_PTRS;
    {
#if (PH3M >> 0) & 1
        { pg8::Gemm g{Zs, WuqT, MT, 768, 384, NZS, 384}; pg8::StaticOrder S; S.init(MT, 768, G, bx); EpiStore E{Qf, 768}; run_gemm4(lds, g, S, E); }
#endif
#if (PH3M >> 1) & 1
        { pg8::Gemm g{Zs + 384, WukvT, MT, 512, 256, NZS, 256}; pg8::StaticOrder S; S.init(MT, 512, G, (bx + G - 192) % G); EpiKnope E{Kf}; run_gemm4(lds, g, S, E); }
#endif
#if (PH3M >> 2) & 1
        { pg8::Gemm g{WukvT + (size_t)512 * 256, Zs + 384, 512, MT, 256, 256, NZS}; pg8::StaticOrder S; S.init(512, MT, G, (bx + G - 64) % G); EpiStore E{VTb, MT}; run_gemm4(lds, g, S, E); }
#endif
#if (PH3M >> 3) & 1
        { pg8::Gemm g{Ure, Bst, 16 * SROWS, 16 * 256, 1024, ULD, 1024}; BatchedOrder S{1, G, (bx + G - 192) % G}; EpiSst E{Sst}; run_gemm4(lds, g, S, E); }
#endif
    }
    }
#endif
    xcd_barrier(xbar);

#if (PHM >> 4) & 1
    for (int rep_ = 0; rep_ < 1 + ((DUPM >> 4) & 1); ++rep_) { DECL_PTRS;
    {
        {
            const int rt = (G - 1 - bx) * NTHR + tid;
            if (rt < 16 * NBATCH * 128) {
                const int p = rt & 63, dir = (rt >> 6) & 1, b = (rt >> 7) % NBATCH, g = (rt >> 7) / NBATCH, gd = dir * 16 + g;
                const float dt = expf(logstep[gd]); float ar, ai; cpowk(lam_re[gd * 64 + p], lam_im[gd * 64 + p], dt, 64, ar, ai);
                float xr = 0.f, xi = 0.f;
                const size_t rbase = (size_t)g * SROWS + (size_t)b * NCHUNK;
                for (int c8 = 0; c8 < NCHUNK; c8 += 8) {
                    float sr[8], si[8];
#pragma unroll
                    for (int i = 0; i < 8; ++i) { const int c = dir == 0 ? c8 + i : NCHUNK - 1 - (c8 + i); const float* sp = Sst + (rbase + c) * 256 + dir * 128 + p; sr[i] = sp[0]; si[i] = sp[64]; }
#pragma unroll
                    for (int i = 0; i < 8; ++i) { const int c = dir == 0 ? c8 + i : NCHUNK - 1 - (c8 + i); bf16* up = Ure + (rbase + c) * ULD + 1024 + dir * 128 + p;
                        up[0] = (bf16)f2bf(xr); up[64] = (bf16)f2bf(xi);
                        const float nr = ar * xr - ai * xi + sr[i], ni = ar * xi + ai * xr + si[i]; xr = nr; xi = ni; }
                }
            }
        }
        const float* gq = a.in[11]; const float* gk = a.in[12];
        for (int m0 = gw * 8; m0 < MT; m0 += NGW * 8) {
            const int row = m0 + (lane >> 3), h = lane & 7, pos = row & (SEQ - 1);
            v4u pc[12];
            { v4u* qp = (v4u*)(Qf + (size_t)row * 768 + h * 96);
#pragma unroll
              for (int i = 0; i < 12; ++i) pc[i] = qp[i];
              head96_norm_rope(pc, gq, pos, QSCALE);
#pragma unroll
              for (int i = 0; i < 12; ++i) qp[i] = pc[i]; }
            { v4u* kp = (v4u*)(Kf + (size_t)row * 768 + h * 96); const v4u* rp = (const v4u*)(Zs + (size_t)row * NZS + 640);
#pragma unroll
              for (int i = 0; i < 8; ++i) pc[i] = kp[i];
#pragma unroll
              for (int i = 0; i < 4; ++i) pc[8 + i] = rp[i];
              head96_norm_rope(pc, gk, pos, 1.0f);
#pragma unroll
              for (int i = 0; i < 12; ++i) kp[i] = pc[i]; }
        }
    }
    }
#endif
    xcd_barrier(xbar);

#if (PHM >> 5) & 1
    for (int rep_ = 0; rep_ < 1 + ((DUPM >> 5) & 1); ++rep_) { DECL_PTRS;
    {
#if (PH5M & 1)
        bool fixref;
        { float gq_ = lane < 48 ? fmaxf(fabsf(a.in[11][lane]), fabsf(a.in[11][lane + 48])) : 0.f, gk_ = lane < 48 ? fmaxf(fabsf(a.in[12][lane]), fabsf(a.in[12][lane + 48])) : 0.f;
#pragma unroll
          for (int o_ = 1; o_ < 64; o_ <<= 1) { gq_ = fmaxf(gq_, __shfl_xor(gq_, o_)); gk_ = fmaxf(gk_, __shfl_xor(gk_, o_)); }
          const float bound_ = 9.797958971f * 1.4426950408889634f * 1.02f * gq_ * gk_;
          fixref = __builtin_amdgcn_readfirstlane((bound_ <= 80.0f) ? 1 : 0) != 0; }
        for (int uidx = vcu; uidx < NBATCH * 8 * 8; uidx += G) {
            const int qb = uidx & 7, bh = uidx >> 3, h = bh & 7, b = bh >> 3;
            const size_t r0 = (size_t)b * SEQ + qb * 512;
            if (fixref) ATT_MAIN(lds, Qf + r0 * 768 + h * 96, 768, Kf + (size_t)b * SEQ * 768 + h * 96, 768, VTb + (size_t)(h * 64) * MT + (size_t)b * SEQ, MT, SEQ, OB + r0 * 1024 + h * 64, 1024);
            else {
#pragma unroll 1
                for (int half = 0; half < 2; ++half) { const size_t r1 = r0 + half * 256;
                    attn_unit<96>(lds, Qf + r1 * 768 + h * 96, 768, Kf + (size_t)b * SEQ * 768 + h * 96, 768, VTb + (size_t)(h * 64) * MT + (size_t)b * SEQ, MT, SEQ, OB + r1 * 1024 + h * 64, 1024); } }
        }
#endif
#if (PH5M & 2)
        const bool deal_ = (G == 256);
        const int mu0_ = deal_ ? (bx < 64 ? 2 * bx : 128 + 6 * (bx - 64)) : vcu, mun_ = deal_ ? (bx < 64 ? 2 : 6) : (NBATCH * 4 * 16 - vcu + G - 1) / G, mus_ = deal_ ? 1 : G;
        for (int mi_ = 0; mi_ < mun_; ++mi_) { const int uidx = mu0_ + mi_ * mus_;
            const int qb = uidx & 15, bh = uidx >> 4, h = bh & 3, b = bh >> 2;
            const size_t r0 = (size_t)b * SEQ + qb * 256;
            attn_unit<64>(lds, MQ + r0 * 256 + h * 64, 256, MK + (size_t)b * MEMTOK * 256 + h * 64, 256, MVT + (size_t)(h * 64) * MMEM + (size_t)b * MEMTOK, MMEM, MEMTOK, OB + r0 * 1024 + 768 + h * 64, 1024);
        }
#endif
        __syncthreads();
#if (PH5M & 4)
        { pg8::Gemm g{Ure, BtY, 16 * SROWS, 16 * 1024, ULD, ULD, ULD}; BatchedOrder S{4, G, bx}; EpiY E{Ure, a.in[20], Yact}; run_gemm(lds, g, S, E); }
#endif
    }
    }
#endif
    xcd_barrier(xbar);

#if (PHM >> 6) & 1
    for (int rep_ = 0; rep_ < 1 + ((DUPM >> 6) & 1); ++rep_) { DECL_PTRS;
    { pg8::Gemm g{Yact, WgluT, MT, 256, 256, 256, 256}; pg8::StaticOrder S; S.init(MT, 256, G, bx); EpiGlu E{Yact, OB + 512, 1024}; run_gemm(lds, g, S, E); }
    }
#endif
    xcd_barrier(xbar);

#if (PHM >> 7) & 1
    for (int rep_ = 0; rep_ < 1 + ((DUPM >> 7) & 1); ++rep_) { DECL_PTRS;
    {
        { pg8::Gemm g{OB, WbT, MT, 1024, 1024, 1024, 1024, Gt}; pg8::StaticOrder S; S.init(MT, 1024, G, bx); EpiBranchF E{Gt, Merged}; run_gemm_hook(lds, g, S, E); }
    }
    }
#endif
    xcd_barrier(xbar);

#if (PHM >> 8) & 1
    for (int rep_ = 0; rep_ < 1 + ((DUPM >> 8) & 1); ++rep_) { DECL_PTRS;
    { pg8::Gemm g{Merged, WoutT, MT, 1024, 1024, 1024, 1024}; pg8::StaticOrder S; S.init(MT, 1024, G, bx); EpiOut E{xp, xs, a.out, H2, (float*)(ws + WS_RSS)}; run_gemm(lds, g, S, E); }
    }
#endif
    xcd_barrier(xbar);

#if (PHM >> 10) & 1
    for (int rep_ = 0; rep_ < 1 + ((DUPM >> 10) & 1); ++rep_) { DECL_PTRS;
    { pg8::Gemm g{H2, WguT, MT, 2 * FFD, 1024, 1024, 1024}; pg8::StaticOrder S; S.init(MT, 2 * FFD, G, (G == 256) ? ((bx & 31) * 8 + (bx >> 5)) : bx); EpiSwiglu E{Act, (const float*)(ws + WS_RSS)}; run_gemm(lds, g, S, E); }
    }
#endif
    xcd_barrier(xbar);

#if (PHM >> 11) & 1
    for (int rep_ = 0; rep_ < 1 + ((DUPM >> 11) & 1); ++rep_) { DECL_PTRS;
    { pg8::Gemm g{Act, WdT, MT, 1024, FFD, FFD, FFD}; pg8::StaticOrder S; S.init(MT, 1024, G, bx); EpiDown E{a.out}; run_gemm(lds, g, S, E); }
    }
#endif
}

extern "C" void kernel_launch(void* const* d_in, const int* in_sizes, int n_in, void* d_out, int out_size, void* d_ws, size_t ws_size, hipStream_t stream) {
    static int grid = 0;
    if (grid == 0) {
        if (n_in != 33 || out_size != MT * DM || ws_size < WS_END) { fprintf(stderr, "kernel_launch: unexpected shapes (n_in %d, out %d, ws %zu)\n", n_in, out_size, ws_size); grid = -1; return; }
        int dev = 0, cus = 0, per_cu = 0;
        (void)hipGetDevice(&dev); (void)hipDeviceGetAttribute(&cus, hipDeviceAttributeMultiprocessorCount, dev);
        if (hipFuncSetAttribute((const void*)fwd_megakernel, hipFuncAttributeMaxDynamicSharedMemorySize, LDS_BYTES) != hipSuccess) { fprintf(stderr, "kernel_launch: hipFuncSetAttribute failed\n"); grid = -1; return; }
        if (hipOccupancyMaxActiveBlocksPerMultiprocessor(&per_cu, (const void*)fwd_megakernel, NTHR, LDS_BYTES) != hipSuccess || per_cu < 1) { fprintf(stderr, "kernel_launch: occupancy query says %d\n", per_cu); per_cu = 1; }
        (void)hipGetLastError();
        grid = cus;
    }
    if (grid < 0) return;
    Args a{};
    for (int i = 0; i < 33; ++i) a.in[i] = (const float*)d_in[i];
    a.out = (float*)d_out; a.ws = (unsigned char*)d_ws;
    (void)hipMemsetAsync((unsigned char*)d_ws + WS_BAR, 0, 16384, stream);
    void* args[] = {&a};
    hipError_t e = hipLaunchCooperativeKernel((const void*)fwd_megakernel, dim3(grid), dim3(NTHR), args, LDS_BYTES, stream);
    if (e != hipSuccess) fprintf(stderr, "kernel_launch: cooperative launch failed: %s (grid %d)\n", hipGetErrorString(e), grid);
}
```
